# Optimizing an MI355X kernel written in HIP

```python
import math, functools
import jax, jax.numpy as jnp
from jax import lax
import numpy as np

D_MODEL = 1024
BATCH = 2
SEQ = 8192
DEPTH = 2

GRID_W = 64
CTX_LEN = 256
DA_HEADS = 4
DA_HEAD_DIM = 64
DA_VDIM = 2 * DA_HEAD_DIM
DA_QK = DA_HEADS * 2 * DA_HEAD_DIM
MLA_HEADS = 8
MLA_NOPE = 64
MLA_ROPE = 32
MLA_V = 64
MLA_Q_RANK = 384
MLA_KV_RANK = 256
HGRN_HEADS = 4
HGRN_DK = 128
HGRN_DV = 128
HGRN_KW = HGRN_HEADS * HGRN_DK
HGRN_VW = HGRN_HEADS * HGRN_DV
SSD_HEADS = 8
SSD_HEAD_DIM = 64
SSD_GROUPS = 2
SSD_STATE = 128
SSD_CONV_W = 5
SSD_INNER = SSD_HEADS * SSD_HEAD_DIM
SSD_BC = SSD_GROUPS * SSD_STATE
SSD_CONV_CH = SSD_INNER + 2 * SSD_BC
MLP_HIDDEN = 4 * D_MODEL
Q_BLOCK = 128
SCAN_CHUNK = 64
ROPE_BASE = 10000.0
NORM_EPS = 1e-6

ATT_SPLITS = (DA_QK, DA_QK, DA_HEADS * DA_VDIM, MLA_Q_RANK, MLA_KV_RANK, MLA_ROPE)
ATT_IN = sum(ATT_SPLITS)
ATT_OUT = DA_HEADS * DA_VDIM + MLA_HEADS * MLA_V
REC_SPLITS = (HGRN_KW, HGRN_KW, HGRN_KW, HGRN_VW, HGRN_VW, SSD_INNER, SSD_CONV_CH, 2 * SSD_HEADS)
REC_IN = sum(REC_SPLITS)
REC_OUT = HGRN_VW + SSD_INNER

kernel_name = 'hybrid_diffattn_mla_hgrn2_ssd_block'


def split_sizes(x, sizes):
    return jnp.split(x, np.cumsum(sizes)[:-1].tolist(), axis=-1)


def rms_norm(x, g):
    xf = x.astype(jnp.float32)
    y = xf * lax.rsqrt(jnp.mean(xf * xf, axis=-1, keepdims=True) + NORM_EPS)
    return (y * g.astype(jnp.float32)).astype(x.dtype)


def modulate(x, g, shift, scale):
    return rms_norm(x, g) * (1 + scale) + shift


def sq_relu_mlp(u, w1, w2):
    return jnp.square(jax.nn.relu(u @ w1)) @ w2


def axial_rope(length, rot_dim):
    rows = length // GRID_W
    row = jnp.repeat(jnp.arange(rows, dtype=jnp.float32), GRID_W)
    col = jnp.tile(jnp.arange(GRID_W, dtype=jnp.float32), rows)
    n_freq = rot_dim // 4
    inv_freq = ROPE_BASE ** (-jnp.arange(n_freq, dtype=jnp.float32) / n_freq)
    ang = jnp.concatenate([row[:, None] * inv_freq, col[:, None] * inv_freq], axis=-1)
    return jnp.cos(ang), jnp.sin(ang)


def apply_rope(x, rope):
    cos, sin = (t.astype(x.dtype) for t in rope)
    half = x.shape[-1] // 2
    x1, x2 = x[..., :half], x[..., half:]
    return jnp.concatenate([x1 * cos - x2 * sin, x1 * sin + x2 * cos], axis=-1)


def block_attention(q, k, v, scale):
    b, m, h, s, dk = q.shape
    qb = q.reshape(b, m, h, s // Q_BLOCK, Q_BLOCK, dk).transpose(3, 0, 1, 2, 4, 5)

    def one_block(qi):
        sc = jnp.einsum('bmhqd,bmhkd->bmhqk', qi, k).astype(jnp.float32) * scale
        p = jax.nn.softmax(sc, axis=-1).astype(v.dtype)
        return jnp.einsum('bmhqk,bhkv->bmhqv', p, v)

    out = lax.map(one_block, qb)
    return out.transpose(1, 2, 3, 0, 4, 5).reshape(b, m, h, s, v.shape[-1])


def att_project(u, w_in, q_norm, w_uq, kv_norm, w_ukv, rope_da, rope_mla):
    b, s, _ = u.shape
    qa, ka, va, cq, ckv, kr = split_sizes(u @ w_in, ATT_SPLITS)
    qa = qa.reshape(b, s, DA_HEADS, 2, DA_HEAD_DIM).transpose(0, 3, 2, 1, 4)
    ka = ka.reshape(b, s, DA_HEADS, 2, DA_HEAD_DIM).transpose(0, 3, 2, 1, 4)
    va = va.reshape(b, s, DA_HEADS, DA_VDIM).transpose(0, 2, 1, 3)
    qm = (rms_norm(cq, q_norm) @ w_uq).reshape(b, s, MLA_HEADS, MLA_NOPE + MLA_ROPE).transpose(0, 2, 1, 3)
    kvm = (rms_norm(ckv, kv_norm) @ w_ukv).reshape(b, s, MLA_HEADS, MLA_NOPE + MLA_V).transpose(0, 2, 1, 3)
    qn, qr = qm[..., :MLA_NOPE], qm[..., MLA_NOPE:]
    kn, vm = kvm[..., :MLA_NOPE], kvm[..., MLA_NOPE:]
    kr = kr[:, None]
    if rope_da is not None:
        qa, ka = apply_rope(qa, rope_da), apply_rope(ka, rope_da)
        qr, kr = apply_rope(qr, rope_mla), apply_rope(kr, rope_mla)
    qm = jnp.concatenate([qn, qr], axis=-1)[:, None]
    km = jnp.concatenate([kn, jnp.broadcast_to(kr, kn.shape[:-1] + (MLA_ROPE,))], axis=-1)[:, None]
    return qa, ka, va, qm, km, vm


def attention_mixer(u_lat, u_ctx, layer, w_in, lam_p, subnorm, q_norm, w_uq, kv_norm, w_ukv, w_out,
                    rope_da, rope_mla, need_ctx):
    lam_init = 0.8 - 0.6 * math.exp(-0.3 * layer)
    lp = lam_p.astype(jnp.float32)
    lam = jnp.exp(jnp.sum(lp[0] * lp[1])) - jnp.exp(jnp.sum(lp[2] * lp[3])) + lam_init
    qa, ka, va, qm, km, vm = att_project(u_lat, w_in, q_norm, w_uq, kv_norm, w_ukv, rope_da, rope_mla)
    qa_c, ka_c, va_c, qm_c, km_c, vm_c = att_project(u_ctx, w_in, q_norm, w_uq, kv_norm, w_ukv, None, None)
    da_scale = DA_HEAD_DIM ** -0.5
    mla_scale = (MLA_NOPE + MLA_ROPE) ** -0.5

    def merge(oa, om):
        b, _, _, s, _ = oa.shape
        ya = rms_norm(oa[:, 0] - lam.astype(oa.dtype) * oa[:, 1], subnorm) * (1 - lam_init)
        ya = ya.transpose(0, 2, 1, 3).reshape(b, s, DA_HEADS * DA_VDIM)
        ym = om[:, 0].transpose(0, 2, 1, 3).reshape(b, s, MLA_HEADS * MLA_V)
        return jnp.concatenate([ya, ym], axis=-1) @ w_out

    oa = block_attention(qa, jnp.concatenate([ka_c, ka], axis=3), jnp.concatenate([va_c, va], axis=2), da_scale)
    om = block_attention(qm, jnp.concatenate([km_c, km], axis=3), jnp.concatenate([vm_c, vm], axis=2), mla_scale)
    y_lat = merge(oa, om)
    y_ctx = None
    if need_ctx:
        y_ctx = merge(block_attention(qa_c, ka_c, va_c, da_scale), block_attention(qm_c, km_c, vm_c, mla_scale))
    return y_lat, y_ctx


def hgrn2_scan(q, k, v, logf, s0):
    dtype = q.dtype
    q, k, v, logf, s0 = (t.astype(jnp.float32) for t in (q, k, v, logf, s0))
    b, L, H, K = q.shape
    V = v.shape[-1]
    nc = L // SCAN_CHUNK

    def chunks(t):
        return t.reshape(b, nc, SCAN_CHUNK, H, t.shape[-1]).transpose(1, 0, 3, 2, 4)

    mask = jnp.tril(jnp.ones((SCAN_CHUNK, SCAN_CHUNK), dtype=bool))[:, :, None]

    def step(S, inp):
        qi, ki, vi, gi = inp
        bc = jnp.cumsum(gi, axis=2)
        rel = bc[:, :, :, None, :] - bc[:, :, None, :, :]
        decay = jnp.exp(jnp.where(mask, rel, -jnp.inf))
        att = jnp.einsum('bhtk,bhtsk,bhsk->bhts', qi, decay, ki)
        o = jnp.einsum('bhts,bhsv->bhtv', att, vi) + jnp.einsum('bhtk,bhkv->bhtv', qi * jnp.exp(bc), S)
        btot = bc[:, :, -1]
        S = jnp.exp(btot)[..., None] * S + jnp.einsum('bhsk,bhsv->bhkv', ki * jnp.exp(btot[:, :, None] - bc), vi)
        return S, o

    S, o = lax.scan(step, s0, (chunks(q), chunks(k), chunks(v), chunks(logf)))
    o = o.transpose(1, 0, 3, 2, 4).reshape(b, L, H, V)
    return S.astype(dtype), o.astype(dtype)


def ssd_scan(x, dt, bm, cm, h0, a_neg):
    dtype = x.dtype
    x, dt, bm, cm, h0, a_neg = (t.astype(jnp.float32) for t in (x, dt, bm, cm, h0, a_neg))
    b, L, H, P = x.shape
    G, N = bm.shape[2], bm.shape[3]
    R = H // G
    nc = L // SCAN_CHUNK
    T = SCAN_CHUNK
    xdt = (x * dt[..., None]).reshape(b, nc, T, G, R, P)
    acum = jnp.cumsum((dt * a_neg).reshape(b, nc, T, G, R).transpose(0, 3, 4, 1, 2), axis=-1)
    bm = bm.reshape(b, nc, T, G, N)
    cm = cm.reshape(b, nc, T, G, N)
    mask = jnp.tril(jnp.ones((T, T), dtype=bool))
    decay = jnp.exp(jnp.where(mask, acum[..., :, None] - acum[..., None, :], -jnp.inf))
    cb = jnp.einsum('bctgn,bcsgn->bgcts', cm, bm)
    y_diag = jnp.einsum('bgrcts,bcsgrp->bctgrp', cb[:, :, None] * decay, xdt)
    w_end = jnp.exp(acum[..., -1:] - acum)
    st = jnp.einsum('bcsgn,bgrcs,bcsgrp->cbgrnp', bm, w_end, xdt)
    a_tot = jnp.moveaxis(jnp.exp(acum[..., -1]), -1, 0)

    def step(h, inp):
        s_c, a_c = inp
        return a_c[..., None, None] * h + s_c, h

    h_fin, h_in = lax.scan(step, h0, (st, a_tot))
    y_off = jnp.einsum('bctgn,cbgrnp,bgrct->bctgrp', cm, h_in, jnp.exp(acum))
    y = (y_diag + y_off).reshape(b, L, H, P)
    return h_fin.astype(dtype), y.astype(dtype)


def bidir(scan_f, scan_b, args_f, args_b, h0_f, h0_b):
    flip = lambda t: jnp.flip(t, axis=1)
    hf, yf = scan_f(*args_f, h0_f)
    hb, yb = scan_b(*[flip(t) for t in args_b], h0_b)
    return yf + flip(yb), hf, hb


def centred_dwconv(x, w, bias):
    pad = SSD_CONV_W // 2
    y = lax.conv_general_dilated(x, w[:, None, :].astype(x.dtype), window_strides=(1,), padding=[(pad, pad)],
                                 dimension_numbers=('NWC', 'WIO', 'NWC'), feature_group_count=x.shape[-1])
    return y + bias


def recurrent_mixer(u_lat, u_ctx, layer, w_in, bound_logits, out_norm, conv_w, conv_b, a_log, dt_bias, skip,
                    ssd_g, w_out, need_ctx):
    gamma = jax.nn.softmax(bound_logits.astype(jnp.float32), axis=0)
    lb = (jnp.cumsum(gamma, axis=0) - gamma[0])[layer]
    lb_f = lb[:HGRN_KW].reshape(HGRN_HEADS, HGRN_DK)
    lb_b = lb[HGRN_KW:].reshape(HGRN_HEADS, HGRN_DK)

    def project(u):
        b, s, _ = u.shape
        q, f_f, f_b, i, g, z, xbc, dt = split_sizes(u @ w_in, REC_SPLITS)
        xbc = jax.nn.silu(centred_dwconv(xbc, conv_w, conv_b))
        xs, bm, cm = split_sizes(xbc, (SSD_INNER, SSD_BC, SSD_BC))
        q = jax.nn.silu(q).reshape(b, s, HGRN_HEADS, HGRN_DK)
        i = i.reshape(b, s, HGRN_HEADS, HGRN_DV)

        def gate_args(f_raw, lower):
            f = lower + (1.0 - lower) * jax.nn.sigmoid(f_raw.astype(jnp.float32).reshape(b, s, HGRN_HEADS, HGRN_DK))
            return (q, 1.0 - f, i, jnp.log(f))

        xs = xs.reshape(b, s, SSD_HEADS, SSD_HEAD_DIM)
        bm = bm.reshape(b, s, SSD_GROUPS, SSD_STATE)
        cm = cm.reshape(b, s, SSD_GROUPS, SSD_STATE)
        ssd_f = (xs, jax.nn.softplus(dt[..., :SSD_HEADS] + dt_bias[0]), bm, cm)
        ssd_b = (xs, jax.nn.softplus(dt[..., SSD_HEADS:] + dt_bias[1]), bm, cm)
        return gate_args(f_f, lb_f), gate_args(f_b, lb_b), ssd_f, ssd_b, (g, z, xs)

    def merge(o, y, extras):
        g, z, xs = extras
        b, s = g.shape[0], g.shape[1]
        o = rms_norm(o, out_norm.reshape(HGRN_HEADS, HGRN_DV)).reshape(b, s, HGRN_VW) * jax.nn.silu(g)
        y = (y + skip[:, None] * xs).reshape(b, s, SSD_INNER) * jax.nn.silu(z)
        y = rms_norm(y.reshape(b, s, SSD_GROUPS, SSD_INNER // SSD_GROUPS),
                     ssd_g.reshape(SSD_GROUPS, SSD_INNER // SSD_GROUPS)).reshape(b, s, SSD_INNER)
        return jnp.concatenate([o, y], axis=-1) @ w_out

    ssd_fwd = functools.partial(ssd_scan, a_neg=-jnp.exp(a_log[0]))
    ssd_bwd = functools.partial(ssd_scan, a_neg=-jnp.exp(a_log[1]))
    hc_f, hc_b, sc_f, sc_b, ex_c = project(u_ctx)
    hl_f, hl_b, sl_f, sl_b, ex_l = project(u_lat)
    b = u_ctx.shape[0]
    zh = jnp.zeros((b, HGRN_HEADS, HGRN_DK, HGRN_DV), u_ctx.dtype)
    zs = jnp.zeros((b, SSD_GROUPS, SSD_HEADS // SSD_GROUPS, SSD_STATE, SSD_HEAD_DIM), u_ctx.dtype)
    oc, st_hf, st_hb = bidir(hgrn2_scan, hgrn2_scan, hc_f, hc_b, zh, zh)
    yc, st_sf, st_sb = bidir(ssd_fwd, ssd_bwd, sc_f, sc_b, zs, zs)
    ol, _, _ = bidir(hgrn2_scan, hgrn2_scan, hl_f, hl_b, st_hf, st_hb)
    yl, _, _ = bidir(ssd_fwd, ssd_bwd, sl_f, sl_b, st_sf, st_sb)
    y_lat = merge(ol, yl, ex_l)
    y_ctx = merge(oc, yc, ex_c) if need_ctx else None
    return y_lat, y_ctx


def setup_inputs(seed: int = 0) -> dict:
    key = jax.random.key(seed)
    ks = iter(jax.random.split(key, 48))
    D = D_MODEL
    n_even, n_odd = (DEPTH + 1) // 2, DEPTH // 2

    def nrm(shape, scale):
        return scale * jax.random.normal(next(ks), shape, jnp.float32)

    def gain(shape):
        return 1.0 + nrm(shape, 0.02)

    inp = {}
    inp['x'] = nrm((BATCH, SEQ, D), 1.0)
    inp['c'] = nrm((BATCH, D), 1.0)
    inp['ctx'] = nrm((BATCH, CTX_LEN, D), 1.0)
    inp['c_ctx'] = nrm((D,), 1.0)
    inp['w_mod'] = nrm((DEPTH, D, 6 * D), 0.5 * D ** -0.5)
    inp['b_mod'] = nrm((DEPTH, 6 * D), 0.01)
    inp['norm_mix'] = gain((DEPTH, D))
    inp['norm_mlp'] = gain((DEPTH, D))
    inp['w_mlp_in'] = nrm((DEPTH, D, MLP_HIDDEN), D ** -0.5)
    inp['w_mlp_out'] = nrm((DEPTH, MLP_HIDDEN, D), MLP_HIDDEN ** -0.5)
    inp['att_w_in'] = nrm((n_even, D, ATT_IN), D ** -0.5)
    inp['att_lambda'] = nrm((n_even, 4, DA_HEAD_DIM), 0.1)
    inp['att_subnorm'] = gain((n_even, DA_VDIM))
    inp['mla_q_norm'] = gain((n_even, MLA_Q_RANK))
    inp['mla_w_uq'] = nrm((n_even, MLA_Q_RANK, MLA_HEADS * (MLA_NOPE + MLA_ROPE)), MLA_Q_RANK ** -0.5)
    inp['mla_kv_norm'] = gain((n_even, MLA_KV_RANK))
    inp['mla_w_ukv'] = nrm((n_even, MLA_KV_RANK, MLA_HEADS * (MLA_NOPE + MLA_V)), MLA_KV_RANK ** -0.5)
    inp['att_w_out'] = nrm((n_even, ATT_OUT, D), ATT_OUT ** -0.5)
    inp['rec_w_in'] = nrm((n_odd, D, REC_IN), D ** -0.5)
    inp['hgrn_bound_logits'] = nrm((DEPTH, 2 * HGRN_KW), 0.5)
    inp['hgrn_out_norm'] = gain((n_odd, HGRN_VW))
    inp['ssd_conv_w'] = nrm((n_odd, SSD_CONV_W, SSD_CONV_CH), SSD_CONV_W ** -0.5)
    inp['ssd_conv_b'] = nrm((n_odd, SSD_CONV_CH), 0.01)
    inp['ssd_a_log'] = jnp.log(jax.random.uniform(next(ks), (n_odd, 2, SSD_HEADS), jnp.float32, 1.0, 16.0))
    dt0 = jnp.exp(jax.random.uniform(next(ks), (n_odd, 2, SSD_HEADS), jnp.float32, math.log(1e-3), math.log(1e-1)))
    inp['ssd_dt_bias'] = dt0 + jnp.log(-jnp.expm1(-dt0))
    inp['ssd_skip'] = 1.0 + nrm((n_odd, SSD_HEADS), 0.1)
    inp['ssd_norm'] = gain((n_odd, SSD_INNER))
    inp['rec_w_out'] = nrm((n_odd, REC_OUT, D), REC_OUT ** -0.5)
    inp['final_norm'] = gain((D,))
    return inp


def reference(x, c, ctx, c_ctx, w_mod, b_mod, norm_mix, norm_mlp, w_mlp_in, w_mlp_out,
              att_w_in, att_lambda, att_subnorm, mla_q_norm, mla_w_uq, mla_kv_norm, mla_w_ukv, att_w_out,
              rec_w_in, hgrn_bound_logits, hgrn_out_norm, ssd_conv_w, ssd_conv_b, ssd_a_log, ssd_dt_bias,
              ssd_skip, ssd_norm, rec_w_out, final_norm):
    L = x.shape[1]
    rope_da = axial_rope(L, DA_HEAD_DIM)
    rope_mla = axial_rope(L, MLA_ROPE)
    h_lat, h_ctx = x, ctx
    for l in range(DEPTH):
        last = l == DEPTH - 1
        j = l // 2
        mod_lat = [m[:, None, :] for m in jnp.split(jax.nn.silu(c) @ w_mod[l] + b_mod[l], 6, axis=-1)]
        mod_ctx = jnp.split(jax.nn.silu(c_ctx) @ w_mod[l] + b_mod[l], 6, axis=-1)
        u_lat = modulate(h_lat, norm_mix[l], mod_lat[0], mod_lat[1])
        u_ctx = modulate(h_ctx, norm_mix[l], mod_ctx[0], mod_ctx[1])
        if l % 2 == 0:
            y_lat, y_ctx = attention_mixer(u_lat, u_ctx, l, att_w_in[j], att_lambda[j], att_subnorm[j],
                                           mla_q_norm[j], mla_w_uq[j], mla_kv_norm[j], mla_w_ukv[j], att_w_out[j],
                                           rope_da, rope_mla, not last)
        else:
            y_lat, y_ctx = recurrent_mixer(u_lat, u_ctx, l, rec_w_in[j], hgrn_bound_logits, hgrn_out_norm[j],
                                           ssd_conv_w[j], ssd_conv_b[j], ssd_a_log[j], ssd_dt_bias[j],
                                           ssd_skip[j], ssd_norm[j], rec_w_out[j], not last)
        h_lat = h_lat + mod_lat[2] * y_lat
        h_lat = h_lat + mod_lat[5] * sq_relu_mlp(modulate(h_lat, norm_mlp[l], mod_lat[3], mod_lat[4]),
                                                 w_mlp_in[l], w_mlp_out[l])
        if not last:
            h_ctx = h_ctx + mod_ctx[2] * y_ctx
            h_ctx = h_ctx + mod_ctx[5] * sq_relu_mlp(modulate(h_ctx, norm_mlp[l], mod_ctx[3], mod_ctx[4]),
                                                     w_mlp_in[l], w_mlp_out[l])
    return rms_norm(h_lat, final_norm)
```

```cpp
#include <hip/hip_runtime.h>
#include <hip/hip_cooperative_groups.h>
#include <cstdio>
namespace cg = cooperative_groups;

typedef unsigned short bf16_t;
using bf16x8 = __attribute__((ext_vector_type(8))) short;
using s16x4  = __attribute__((ext_vector_type(4))) short;
using f32x16 = __attribute__((ext_vector_type(16))) float;
using u32x4 = __attribute__((ext_vector_type(4))) unsigned;
using u32x2 = __attribute__((ext_vector_type(2))) unsigned;
#define DI __device__ __forceinline__
#define MFMA32(a, b, c) __builtin_amdgcn_mfma_f32_32x32x16_bf16((a), (b), (c), 0, 0, 0)

constexpr int D = 1024, NB = 2, SEQ = 8192, NCTX = 256;
constexpr int RB = NCTX + SEQ;
constexpr int R = NB * RB;
constexpr int ATT_IN = 2208, ATT_IN_PAD = 2304;
constexpr int REC_IN = 4112, REC_IN_PAD = 4224;
constexpr int HID = 4096;
constexpr float EPS = 1e-6f;
constexpr float LOG2E = 1.4426950408889634f;

constexpr size_t SZ_WT_ATT_IN = (size_t)ATT_IN_PAD * 1024 * 2;
constexpr size_t SZ_WT_UQ = (size_t)768 * 384 * 2;
constexpr size_t SZ_WT_UKV = (size_t)1024 * 256 * 2;
constexpr size_t SZ_WT_SQ = (size_t)1024 * 1024 * 2;
constexpr size_t SZ_WT_REC_IN = (size_t)REC_IN_PAD * 1024 * 2;
constexpr size_t SZ_WT_MLP = (size_t)2 * 4096 * 1024 * 2;
constexpr size_t SZ_WT_MLP1 = (size_t)4096 * 1024 * 2;
constexpr size_t OFF_WT_REC_OUT = 0;
constexpr size_t OFF_WT_MLP_IN1 = OFF_WT_REC_OUT + SZ_WT_SQ;
constexpr size_t OFF_WT_MLP_OUT1 = OFF_WT_MLP_IN1 + SZ_WT_MLP1;
constexpr size_t OFF_U = OFF_WT_MLP_OUT1 + SZ_WT_MLP1;
constexpr size_t SZ_U = (size_t)R * 1024 * 2;
constexpr size_t OFF_MODV = OFF_U + SZ_U;
constexpr size_t SZ_MODV = (size_t)2 * 3 * 6144 * 4;
constexpr size_t OFF_LB = OFF_MODV + SZ_MODV;
constexpr size_t OFF_HCTX = OFF_LB + 4096;
constexpr size_t SZ_HCTX = (size_t)NB * NCTX * 1024 * 4;
constexpr size_t OFF_DT = OFF_HCTX + SZ_HCTX;
constexpr size_t SZ_DT = (size_t)R * 16 * 4;
constexpr size_t OFF_BIG = OFF_DT + SZ_DT;
constexpr size_t SZ_R512 = (size_t)R * 512 * 2;
constexpr size_t OFF_QDA = OFF_BIG;
constexpr size_t OFF_KDA = OFF_QDA + SZ_R512;
constexpr size_t OFF_VDAT = OFF_KDA + SZ_R512;
constexpr size_t OFF_CQ = OFF_VDAT + SZ_R512;
constexpr size_t OFF_CKV = OFF_CQ + (size_t)R * 384 * 2;
constexpr size_t OFF_KR = OFF_CKV + (size_t)R * 256 * 2;
constexpr size_t OFF_QMLA = OFF_KR + (size_t)R * 32 * 2;
constexpr size_t OFF_KMLA = OFF_QMLA + (size_t)R * 768 * 2;
constexpr size_t OFF_VMLAT = OFF_KMLA + (size_t)R * 768 * 2;
constexpr size_t OFF_OA1 = OFF_VMLAT + SZ_R512;
constexpr size_t OFF_P1 = OFF_BIG;
constexpr size_t OFF_XBC = OFF_P1 + (size_t)R * 3072 * 2;
constexpr size_t OFF_ST = OFF_XBC;
constexpr size_t OFF_XC = OFF_XBC + (size_t)R * 1024 * 2;
constexpr size_t OFF_DEC = OFF_XC + (size_t)R * 1024 * 2;
constexpr size_t OFF_DEC2 = OFF_DEC + (size_t)1056 * 128 * 4;
constexpr size_t OFF_TAIL = (OFF_DEC2 + (size_t)2112 * 128 * 4 + 255) / 256 * 256;
constexpr size_t OFF_WT_ATT_IN = OFF_TAIL;
constexpr size_t OFF_WT_UQ = OFF_WT_ATT_IN + SZ_WT_ATT_IN;
constexpr size_t OFF_WT_UKV = OFF_WT_UQ + SZ_WT_UQ;
constexpr size_t OFF_WT_ATT_OUT = OFF_WT_UKV + SZ_WT_UKV;
constexpr size_t OFF_WT_REC_IN = OFF_WT_ATT_OUT + SZ_WT_SQ;
constexpr size_t OFF_WT_MLP_IN0 = OFF_WT_REC_IN + SZ_WT_REC_IN;
constexpr size_t OFF_WT_MLP_OUT0 = OFF_WT_MLP_IN0 + SZ_WT_MLP1;
constexpr size_t OFF_END = OFF_WT_MLP_OUT0 + SZ_WT_MLP1;
constexpr size_t OFF_ST2 = OFF_TAIL;
constexpr size_t OFF_HID = OFF_BIG;
constexpr size_t OFF_BAR = (size_t)256 * 1024 * 1024 - 16384;
static_assert(OFF_END <= OFF_BAR, "workspace overflow");
static_assert(OFF_ST2 + (size_t)2112 * 64 * 128 * 2 <= OFF_BAR, "SSD state buffer does not fit behind the dead-weights tail");
static_assert(OFF_OA1 + SZ_R512 <= OFF_END, "layer0 overflow");

struct Params {
  const float *x, *c, *ctx, *c_ctx, *w_mod, *b_mod, *norm_mix, *norm_mlp, *w_mlp_in, *w_mlp_out;
  const float *att_w_in, *att_lambda, *att_subnorm, *mla_q_norm, *mla_w_uq, *mla_kv_norm, *mla_w_ukv, *att_w_out;
  const float *rec_w_in, *hgrn_bound_logits, *hgrn_out_norm, *ssd_conv_w, *ssd_conv_b, *ssd_a_log, *ssd_dt_bias;
  const float *ssd_skip, *ssd_norm, *rec_w_out, *final_norm;
  float* out;
  char* ws;
};

DI int get_tid() { int t = threadIdx.x; asm volatile("" : "+v"(t)); return t; }
DI float bf2f(bf16_t u) { return __uint_as_float(((unsigned)u) << 16); }
typedef __bf16 hbf2 __attribute__((ext_vector_type(2)));
typedef float hf2 __attribute__((ext_vector_type(2)));
DI bf16_t f2bf(float x) { __bf16 b = (__bf16)x; return __builtin_bit_cast(unsigned short, b); }
DI unsigned pack2(float a, float b) { hf2 v = {a, b}; hbf2 r = __builtin_convertvector(v, hbf2); return __builtin_bit_cast(unsigned, r); }
DI float max3f(float a, float b, float c) { float r; asm("v_max3_f32 %0, %1, %2, %3" : "=v"(r) : "v"(a), "v"(b), "v"(c)); return r; }
DI float xmax(float x) {
  const unsigned u = __float_as_uint(x);
  auto rr = __builtin_amdgcn_permlane32_swap(u, u, false, false);
  return fmaxf(__uint_as_float(rr[0]), __uint_as_float(rr[1]));
}
DI float xsum(float x) {
  const unsigned u = __float_as_uint(x);
  auto rr = __builtin_amdgcn_permlane32_swap(u, u, false, false);
  return __uint_as_float(rr[0]) + __uint_as_float(rr[1]);
}
DI float silu_f(float x) { return x / (1.f + __expf(-x)); }
DI float sigmoid_f(float x) { return 1.f / (1.f + __expf(-x)); }
DI float wave_sum(float v) {
#pragma unroll
  for (int o = 32; o >= 1; o >>= 1) v += __shfl_xor(v, o, 64);
  return v;
}
DI int row_b(int row) { return row >= RB ? 1 : 0; }

DI void transpose_task(const float* __restrict__ src, int K, int N, int Npad, bf16_t* __restrict__ dst, float* tile, int rot, bool ukv_perm = false) {
  const int tid = get_tid();
  const int tk = K / 64, tn = Npad / 64, ntile = tk * tn;
  const int nb = gridDim.x;
  for (int t0 = (blockIdx.x + rot) % nb; t0 < ntile; t0 += 2 * nb) {
    float4 v[2][4];
#pragma unroll
    for (int u = 0; u < 2; u++) {
      const int t = t0 + u * nb;
      if (t < ntile) {
        const int k0 = (t % tk) * 64, n0 = (t / tk) * 64;
#pragma unroll
        for (int i = 0; i < 4; i++) {
          const int c = tid + 256 * i, kk = c >> 4, n4 = (c & 15) * 4;
          const int n = n0 + n4;
          const float* sp = src + (size_t)(k0 + kk) * N + n;
          if (n + 3 < N) v[u][i] = *(const float4*)sp;
          else { v[u][i].x = n < N ? sp[0] : 0.f; v[u][i].y = n + 1 < N ? sp[1] : 0.f; v[u][i].z = n + 2 < N ? sp[2] : 0.f; v[u][i].w = 0.f; }
        }
      }
    }
    __syncthreads();
#pragma unroll
    for (int u = 0; u < 2; u++)
#pragma unroll
      for (int i = 0; i < 4; i++) {
        const int c = tid + 256 * i, kk = c >> 4, n4 = (c & 15) * 4;
        float* tp = tile + u * (64 * 65) + kk * 65 + n4;
        tp[0] = v[u][i].x; tp[1] = v[u][i].y; tp[2] = v[u][i].z; tp[3] = v[u][i].w;
      }
    __syncthreads();
#pragma unroll
    for (int u = 0; u < 2; u++) {
      const int t = t0 + u * nb;
      if (t < ntile) {
        const int k0 = (t % tk) * 64, n0 = (t / tk) * 64;
#pragma unroll
        for (int i = 0; i < 2; i++) {
          const int c = tid + 256 * i, nn = c >> 3, kc = (c & 7) * 8;
          const float* tp = tile + u * (64 * 65) + kc * 65 + nn;
          u32x4 o;
          o.x = pack2(tp[0], tp[65]); o.y = pack2(tp[130], tp[195]); o.z = pack2(tp[260], tp[325]); o.w = pack2(tp[390], tp[455]);
          int nd = n0 + nn;
          if (ukv_perm) { const int e = nd & 127, hh = nd >> 7; nd = e < 64 ? hh * 64 + e : 512 + hh * 64 + (e - 64); }
          *(u32x4*)(dst + (size_t)nd * K + k0 + kc) = o;
        }
      }
    }
  }
}

DI void mod_task(const Params& p, int t, float* sm) {
  const int tid = get_tid();
  float* sv = sm;
  float* red = sm + 3072;
  const int l = t / 192, n0 = (t % 192) * 32;
  __syncthreads();
  for (int i = tid; i < 3072; i += 256) {
    int which = i >> 10, k = i & 1023;
    float v = which == 0 ? p.c[k] : (which == 1 ? p.c[1024 + k] : p.c_ctx[k]);
    sv[i] = silu_f(v);
  }
  __syncthreads();
  const int col = tid & 31, kq = tid >> 5;
  const float* w = p.w_mod + (size_t)l * 1024 * 6144 + n0 + col;
  float a0 = 0.f, a1 = 0.f, a2 = 0.f;
#pragma unroll 32
  for (int k = kq * 128; k < kq * 128 + 128; k++) {
    float wv = w[(size_t)k * 6144];
    a0 += sv[k] * wv; a1 += sv[1024 + k] * wv; a2 += sv[2048 + k] * wv;
  }
  red[(kq * 3 + 0) * 32 + col] = a0; red[(kq * 3 + 1) * 32 + col] = a1; red[(kq * 3 + 2) * 32 + col] = a2;
  __syncthreads();
  if (tid < 96) {
    int i = tid >> 5, cc = tid & 31;
    float sacc = p.b_mod[l * 6144 + n0 + cc];
    for (int q = 0; q < 8; q++) sacc += red[(q * 3 + i) * 32 + cc];
    float* modv = (float*)(p.ws + OFF_MODV);
    modv[(l * 3 + i) * 6144 + n0 + cc] = sacc;
  }
}

DI void norm_mod_phase(const Params& p, int l, int which, bool from_input, bool lat_only, const float* ctxp = nullptr, int padd_l = 0, int padd_g = 0, bool ctx_base_input = false) {
  const int lane = get_tid() & 63, w = get_tid() >> 6;
  const float* modv = (const float*)(p.ws + OFF_MODV);
  const float* gain = (which == 0 ? p.norm_mix : p.norm_mlp) + l * 1024;
  bf16_t* U = (bf16_t*)(p.ws + OFF_U);
  const float* hctx = (const float*)(p.ws + OFF_HCTX);
  const int nrow = lat_only ? NB * SEQ : R, stride = gridDim.x * 4;
  auto rowof = [&](int ri) { return lat_only ? (ri >> 13) * RB + NCTX + (ri & (SEQ - 1)) : ri; };
  auto srcof = [&](int row) -> const float* {
    const int b = row_b(row), pos = row - b * RB;
    if (pos < NCTX) return ((from_input || ctx_base_input) ? p.ctx : hctx) + (size_t)(b * NCTX + pos) * 1024;
    return (from_input ? p.x : (const float*)p.out) + (size_t)(b * SEQ + pos - NCTX) * 1024;
  };
  int ri = blockIdx.x * 4 + w;
  float4 v[4], vn[4];
  if (ri < nrow) {
    const float* src = srcof(rowof(ri));
#pragma unroll
    for (int i = 0; i < 4; i++) v[i] = *(const float4*)(src + i * 256 + lane * 4);
  }
  for (; ri < nrow; ri += stride) {
    const int row = rowof(ri);
    {
      const int rn = ri + stride < nrow ? ri + stride : ri;
      const float* srcn = srcof(rowof(rn));
#pragma unroll
      for (int i = 0; i < 4; i++) vn[i] = *(const float4*)(srcn + i * 256 + lane * 4);
    }
    const int b = row_b(row), pos = row - b * RB;
    const bool isctx = pos < NCTX;
    const float* mv = modv + (size_t)(l * 3 + (isctx ? 2 : b)) * 6144;
    const float* shift = mv + (which ? 3 : 0) * 1024;
    const float* scale = mv + (which ? 4 : 1) * 1024;
    if (ctxp != nullptr && isctx) {
      const float* gate = modv + (size_t)(padd_l * 3 + 2) * 6144 + padd_g * 1024;
      const size_t crow = (size_t)(b * NCTX + pos);
      float* hc = (float*)(p.ws + OFF_HCTX) + crow * 1024;
#pragma unroll
      for (int i = 0; i < 4; i++) {
        const int cidx = i * 256 + lane * 4;
        float4 acc = *(const float4*)(ctxp + crow * 1024 + cidx);
#pragma unroll
        for (int q = 1; q < 4; q++) {
          const float4 t = *(const float4*)(ctxp + ((size_t)q * (NB * NCTX) + crow) * 1024 + cidx);
          acc.x += t.x; acc.y += t.y; acc.z += t.z; acc.w += t.w;
        }
        const float4 g4 = *(const float4*)(gate + cidx);
        v[i].x += g4.x * acc.x; v[i].y += g4.y * acc.y; v[i].z += g4.z * acc.z; v[i].w += g4.w * acc.w;
        *(float4*)(hc + cidx) = v[i];
      }
    }
    float ss = 0.f;
#pragma unroll
    for (int i = 0; i < 4; i++) ss += v[i].x * v[i].x + v[i].y * v[i].y + v[i].z * v[i].z + v[i].w * v[i].w;
    ss = wave_sum(ss);
    const float rstd = rsqrtf(ss * (1.f / 1024.f) + EPS);
#pragma unroll
    for (int i = 0; i < 4; i++) {
      int cidx = i * 256 + lane * 4;
      float4 g = *(const float4*)(gain + cidx), sh = *(const float4*)(shift + cidx), sc = *(const float4*)(scale + cidx);
      float o0 = v[i].x * rstd * g.x * (1.f + sc.x) + sh.x;
      float o1 = v[i].y * rstd * g.y * (1.f + sc.y) + sh.y;
      float o2 = v[i].z * rstd * g.z * (1.f + sc.z) + sh.z;
      float o3 = v[i].w * rstd * g.w * (1.f + sc.w) + sh.w;
      u32x2 pk; pk.x = pack2(o0, o1); pk.y = pack2(o2, o3);
      *(u32x2*)(U + (size_t)row * 1024 + cidx) = pk;
    }
#pragma unroll
    for (int i = 0; i < 4; i++) v[i] = vn[i];
  }
}

constexpr int CS = 132;
constexpr int GS = 72;
template <class Epi>
DI void gemm_tile(const bf16_t* __restrict__ A, int lda, const bf16_t* __restrict__ Bt, int ldb, int K, int m0, int n0,
                  const Epi& epi, bf16_t* sa, bf16_t* sb) {
  const int tid = get_tid(), lane = tid & 63, w = tid >> 6, r = lane & 31, h = lane >> 5;
  const int wm = w >> 1, wn = w & 1;
  f32x16 acc[2][2];
#pragma unroll
  for (int i = 0; i < 2; i++)
#pragma unroll
    for (int j = 0; j < 2; j++)
#pragma unroll
      for (int e = 0; e < 16; e++) acc[i][j][e] = 0.f;
  const int lrow = tid >> 3, lc = (tid & 7) * 8;
  const bf16_t* ga = A + (size_t)(m0 + lrow) * lda + lc;
  const bf16_t* gb = Bt + (size_t)(n0 + lrow) * ldb + lc;
  u32x4 ra[4], rb[4];
  const int nk = K >> 6;
#pragma unroll
  for (int i = 0; i < 4; i++) {
    ra[i] = *(const u32x4*)(ga + (size_t)(32 * i) * lda);
    rb[i] = *(const u32x4*)(gb + (size_t)(32 * i) * ldb);
  }
  for (int kt = 0; kt < nk; kt++) {
    bf16_t* pa = sa + (kt & 1) * (128 * GS);
    bf16_t* pb = sb + (kt & 1) * (128 * GS);
#pragma unroll
    for (int i = 0; i < 4; i++) {
      *(u32x4*)(pa + (lrow + 32 * i) * GS + lc) = ra[i];
      *(u32x4*)(pb + (lrow + 32 * i) * GS + lc) = rb[i];
    }
    __syncthreads();
    {
      const int k0 = (kt + 1 < nk ? kt + 1 : kt) << 6;
#pragma unroll
      for (int i = 0; i < 4; i++) {
        ra[i] = *(const u32x4*)(ga + (size_t)(32 * i) * lda + k0);
        rb[i] = *(const u32x4*)(gb + (size_t)(32 * i) * ldb + k0);
      }
    }
    __builtin_amdgcn_sched_barrier(0);
#pragma unroll
    for (int s = 0; s < 4; s++) {
      bf16x8 af[2], bq[2];
#pragma unroll
      for (int i = 0; i < 2; i++) af[i] = *(const bf16x8*)(pa + (wm * 64 + i * 32 + r) * GS + s * 16 + h * 8);
#pragma unroll
      for (int j = 0; j < 2; j++) bq[j] = *(const bf16x8*)(pb + (wn * 64 + j * 32 + r) * GS + s * 16 + h * 8);
#pragma unroll
      for (int i = 0; i < 2; i++)
#pragma unroll
        for (int j = 0; j < 2; j++) acc[i][j] = MFMA32(bq[j], af[i], acc[i][j]);
    }
  }
  __syncthreads();
  float* Cs = (float*)sa;
  const bool tr = epi.transposed(n0);
#pragma unroll
  for (int i = 0; i < 2; i++)
#pragma unroll
    for (int j = 0; j < 2; j++)
#pragma unroll
      for (int g = 0; g < 4; g++) {
        const int m = wm * 64 + i * 32 + r, n = wn * 64 + j * 32 + 8 * g + 4 * h;
        if (!tr) {
          float4 v; v.x = acc[i][j][4 * g]; v.y = acc[i][j][4 * g + 1]; v.z = acc[i][j][4 * g + 2]; v.w = acc[i][j][4 * g + 3];
          *(float4*)(Cs + m * CS + n) = v;
        } else {
          Cs[(n + 0) * CS + m] = acc[i][j][4 * g]; Cs[(n + 1) * CS + m] = acc[i][j][4 * g + 1];
          Cs[(n + 2) * CS + m] = acc[i][j][4 * g + 2]; Cs[(n + 3) * CS + m] = acc[i][j][4 * g + 3];
        }
      }
  __syncthreads();
  epi.store(Cs, m0, n0);
  __syncthreads();
}

template <class Epi>
DI void gemm_phase(const bf16_t* A, int lda, const bf16_t* Bt, int ldb, int M, int Npad, int K, int mode  , const Epi& epi,
                   char* smem, int ntile_lo = 0) {
  bf16_t* sa = (bf16_t*)smem;
  bf16_t* sb = sa + 2 * 128 * GS;
  const int tn = Npad / 128 - ntile_lo, tm = mode == 1 ? (NB * SEQ) / 128 : (mode == 2 ? (NB * NCTX) / 128 : M / 128);
  const int xcd = blockIdx.x & 7, rank = blockIdx.x >> 3, per = gridDim.x >> 3;
  const int mlo = (xcd * tm) >> 3, mhi = ((xcd + 1) * tm) >> 3, tmx = mhi - mlo;
  const int full = tmx >> 3, nfull = full * 8 * tn;
  for (int L = rank; L < tmx * tn; L += per) {
    int mt, nt_;
    if (L < nfull) { const int panel = L / (8 * tn), rem = L - panel * 8 * tn; nt_ = rem >> 3; mt = mlo + panel * 8 + (rem & 7); }
    else { const int rem = L - nfull, ph = tmx - full * 8; nt_ = rem / ph; mt = mlo + full * 8 + (rem - nt_ * ph); }
    const int n0 = (nt_ + ntile_lo) * 128;
    const int m0 = mode == 1 ? (mt >> 6) * RB + NCTX + (mt & 63) * 128 : (mode == 2 ? (mt >> 1) * RB + (mt & 1) * 128 : mt * 128);
    gemm_tile(A, lda, Bt, ldb, K, m0, n0, epi, sa, sb);
  }
}

DI void ld8f(const float* p, float* o) {
  const float4 a = *(const float4*)p, b = *(const float4*)(p + 4);
  o[0] = a.x; o[1] = a.y; o[2] = a.z; o[3] = a.w; o[4] = b.x; o[5] = b.y; o[6] = b.z; o[7] = b.w;
}
DI u32x4 pk8(const float* v) { u32x4 o; o.x = pack2(v[0], v[1]); o.y = pack2(v[2], v[3]); o.z = pack2(v[4], v[5]); o.w = pack2(v[6], v[7]); return o; }

struct EpiAttIn {
  char* ws;
  DI bool transposed(int n0) const { return n0 >= 1024 && n0 < 1536; }
  DI void store(const float* Cs, int m0, int n0) const {
    const int tid = get_tid();
    const int b = row_b(m0), pos0 = m0 - b * RB;
#pragma unroll 2
    for (int i = 0; i < 8; i++) {
      const int c = tid + 256 * i, row = c >> 4, ch = c & 15;
      float v[8]; ld8f(Cs + row * CS + ch * 8, v);
      const u32x4 o = pk8(v);
      if (n0 < 1024) {
        const int hh = (n0 & 511) >> 7, m = ch >> 3, d0 = (ch & 7) * 8;
        bf16_t* dst = (bf16_t*)(ws + (n0 < 512 ? OFF_QDA : OFF_KDA)) + ((size_t)((b * 2 + m) * 4 + hh) * RB + pos0 + row) * 64 + d0;
        *(u32x4*)dst = o;
      } else if (n0 < 1536) {
        const int hh = (n0 - 1024) >> 7;
        bf16_t* dst = (bf16_t*)(ws + OFF_VDAT) + ((size_t)((b * 4 + hh) * 128 + row)) * RB + pos0 + ch * 8;
        *(u32x4*)dst = o;
      } else if (n0 < 1920) {
        *(u32x4*)((bf16_t*)(ws + OFF_CQ) + (size_t)(m0 + row) * 384 + (n0 - 1536) + ch * 8) = o;
      } else if (n0 < 2176) {
        *(u32x4*)((bf16_t*)(ws + OFF_CKV) + (size_t)(m0 + row) * 256 + (n0 - 1920) + ch * 8) = o;
      } else if (ch < 4) {
        *(u32x4*)((bf16_t*)(ws + OFF_KR) + (size_t)(m0 + row) * 32 + ch * 8) = o;
      }
    }
  }
};
struct EpiUq {
  char* ws;
  DI bool transposed(int) const { return false; }
  DI void store(const float* Cs, int m0, int n0) const {
    const int tid = get_tid();
    const int b = row_b(m0), pos0 = m0 - b * RB;
#pragma unroll 2
    for (int i = 0; i < 8; i++) {
      const int c = tid + 256 * i, row = c >> 4, ch = c & 15;
      float v[8]; ld8f(Cs + row * CS + ch * 8, v);
      const int col0 = n0 + ch * 8, hh = col0 / 96, e0 = col0 - hh * 96;
      *(u32x4*)((bf16_t*)(ws + OFF_QMLA) + ((size_t)(b * 8 + hh) * RB + pos0 + row) * 96 + e0) = pk8(v);
    }
  }
};
struct EpiUkv {
  char* ws;
  DI bool transposed(int n0) const { return n0 >= 512; }
  DI void store(const float* Cs, int m0, int n0) const {
    const int tid = get_tid();
    const int b = row_b(m0), pos0 = m0 - b * RB;
#pragma unroll 2
    for (int i = 0; i < 8; i++) {
      const int c = tid + 256 * i, row = c >> 4, ch = c & 15;
      float v[8]; ld8f(Cs + row * CS + ch * 8, v);
      if (n0 < 512) {
        const int col0 = n0 + ch * 8, hh = col0 >> 6, e0 = col0 & 63;
        *(u32x4*)((bf16_t*)(ws + OFF_KMLA) + ((size_t)(b * 8 + hh) * RB + pos0 + row) * 96 + e0) = pk8(v);
      } else {
        const int nn = n0 - 512 + row, hh = nn >> 6, dv = nn & 63;
        *(u32x4*)((bf16_t*)(ws + OFF_VMLAT) + ((size_t)((b * 8 + hh) * 64 + dv)) * RB + pos0 + ch * 8) = pk8(v);
      }
    }
  }
};
struct EpiResid {
  const float* x; const float* ctx; float* hlat; float* hctx; const float* modv_l; int gidx; bool from_input;
  DI bool transposed(int) const { return false; }
  DI void store(const float* Cs, int m0, int n0) const {
    const int tid = get_tid();
    const int b = row_b(m0), pos0 = m0 - b * RB;
    const bool isctx = pos0 < NCTX;
    const float* gate = modv_l + (size_t)(isctx ? 2 : b) * 6144 + gidx * 1024 + n0;
    const float* src = isctx ? (from_input ? ctx : hctx) : (from_input ? x : hlat);
    float* dst = isctx ? hctx : hlat;
    const size_t rbase = isctx ? (size_t)(b * NCTX + pos0) : (size_t)(b * SEQ + pos0 - NCTX);
#pragma unroll 4
    for (int i = 0; i < 16; i++) {
      const int c = tid + 256 * i, row = c >> 5, ch = c & 31;
      const float4 v = *(const float4*)(Cs + row * CS + ch * 4);
      const float4 g = *(const float4*)(gate + ch * 4);
      const size_t o = (rbase + row) * 1024 + n0 + ch * 4;
      const float4 hv = *(const float4*)(src + o);
      float4 r4; r4.x = hv.x + g.x * v.x; r4.y = hv.y + g.y * v.y; r4.z = hv.z + g.z * v.z; r4.w = hv.w + g.w * v.w;
      *(float4*)(dst + o) = r4;
    }
  }
};
struct EpiCtxPartial {
  float* ctxp; int ks;
  DI bool transposed(int) const { return false; }
  DI void store(const float* Cs, int m0, int n0) const {
    const int tid = get_tid();
    const int b = row_b(m0), pos0 = m0 - b * RB;
    float* dst = ctxp + ((size_t)ks * (NB * NCTX) + (size_t)(b * NCTX + pos0)) * 1024 + n0;
#pragma unroll 4
    for (int i = 0; i < 16; i++) {
      const int c = tid + 256 * i, row = c >> 5, ch = c & 31;
      *(float4*)(dst + (size_t)row * 1024 + ch * 4) = *(const float4*)(Cs + row * CS + ch * 4);
    }
  }
};
struct EpiMlpIn {
  bf16_t* hid;
  DI bool transposed(int) const { return false; }
  DI void store(const float* Cs, int m0, int n0) const {
    const int tid = get_tid();
#pragma unroll 2
    for (int i = 0; i < 8; i++) {
      const int c = tid + 256 * i, row = c >> 4, ch = c & 15;
      float v[8]; ld8f(Cs + row * CS + ch * 8, v);
#pragma unroll
      for (int q = 0; q < 8; q++) { const float t = fmaxf(v[q], 0.f); v[q] = t * t; }
      *(u32x4*)(hid + (size_t)(m0 + row) * HID + n0 + ch * 8) = pk8(v);
    }
  }
};
struct EpiRecIn {
  char* ws; const float* dt_bias;
  DI bool transposed(int) const { return false; }
  DI void store(const float* Cs, int m0, int n0) const {
    const int tid = get_tid();
    if (n0 < 4096) {
      const int seg = n0 >> 9;
#pragma unroll 2
      for (int i = 0; i < 8; i++) {
        const int c = tid + 256 * i, row = c >> 4, ch = c & 15;
        float v[8]; ld8f(Cs + row * CS + ch * 8, v);
        if (seg == 0 || seg == 4 || seg == 5) {
#pragma unroll
          for (int q = 0; q < 8; q++) v[q] = silu_f(v[q]);
        } else if (seg == 1 || seg == 2) {
          const float* lb = (const float*)(ws + OFF_LB) + (n0 - 512) + ch * 8;
#pragma unroll
          for (int q = 0; q < 8; q++) v[q] = __logf(lb[q] + (1.f - lb[q]) * sigmoid_f(v[q]));
        }
        if (n0 < 3072) *(u32x4*)((bf16_t*)(ws + OFF_P1) + (size_t)(m0 + row) * 3072 + n0 + ch * 8) = pk8(v);
        else *(u32x4*)((bf16_t*)(ws + OFF_XBC) + (size_t)(m0 + row) * 1024 + (n0 - 3072) + ch * 8) = pk8(v);
      }
    } else {
      const int row = tid >> 1, c0 = (tid & 1) * 8;
      float* DT = (float*)(ws + OFF_DT) + (size_t)(m0 + row) * 16 + c0;
#pragma unroll
      for (int q = 0; q < 8; q++) {
        const float t = Cs[row * CS + c0 + q] + dt_bias[c0 + q];
        DT[q] = t > 20.f ? t : log1pf(__expf(t));
      }
    }
  }
};

DI void gemm_ctx_splitk(const bf16_t* A, int lda, const bf16_t* Bt, int ldb, int K, float* ctxp, char* smem) {
  bf16_t* sa = (bf16_t*)smem;
  bf16_t* sb = sa + 2 * 128 * GS;
  const int kslice = K >> 2;
  for (int u = gridDim.x - 1 - blockIdx.x; u < 128; u += gridDim.x) {
    const int ks = u & 3, t = u >> 2, nt_ = t & 7, mt = t >> 3;
    const int m0 = (mt >> 1) * RB + (mt & 1) * 128, n0 = nt_ * 128;
    gemm_tile(A + ks * kslice, lda, Bt + ks * kslice, ldb, kslice, m0, n0, EpiCtxPartial{ctxp, ks}, sa, sb);
  }
}

template <class Epi>
DI void gemm_tile256(const bf16_t* __restrict__ A, int lda, const bf16_t* __restrict__ Bt, int ldb, int K, int m0, int n0,
                     const Epi& epi, bf16_t* sa, bf16_t* sb) {
  const int tid = get_tid(), lane = tid & 63, w = tid >> 6, r = lane & 31, h = lane >> 5;
  const int wm = w >> 1, wn = w & 1;
  f32x16 acc[2][4];
#pragma unroll
  for (int i = 0; i < 2; i++)
#pragma unroll
    for (int j = 0; j < 4; j++)
#pragma unroll
      for (int e = 0; e < 16; e++) acc[i][j][e] = 0.f;
  const int lrow = tid >> 3, lc = (tid & 7) * 8;
  const bf16_t* ga = A + (size_t)(m0 + lrow) * lda + lc;
  const bf16_t* gb = Bt + (size_t)(n0 + lrow) * ldb + lc;
  u32x4 ra[4], rb[8];
  const int nk = K >> 6;
#pragma unroll
  for (int i = 0; i < 4; i++) ra[i] = *(const u32x4*)(ga + (size_t)(32 * i) * lda);
#pragma unroll
  for (int i = 0; i < 8; i++) rb[i] = *(const u32x4*)(gb + (size_t)(32 * i) * ldb);
  for (int kt = 0; kt < nk; kt++) {
    __syncthreads();
#pragma unroll
    for (int i = 0; i < 4; i++) *(u32x4*)(sa + (lrow + 32 * i) * GS + lc) = ra[i];
#pragma unroll
    for (int i = 0; i < 8; i++) *(u32x4*)(sb + (lrow + 32 * i) * GS + lc) = rb[i];
    __syncthreads();
    {
      const int k0 = (kt + 1 < nk ? kt + 1 : kt) << 6;
#pragma unroll
      for (int i = 0; i < 4; i++) ra[i] = *(const u32x4*)(ga + (size_t)(32 * i) * lda + k0);
#pragma unroll
      for (int i = 0; i < 8; i++) rb[i] = *(const u32x4*)(gb + (size_t)(32 * i) * ldb + k0);
    }
    __builtin_amdgcn_sched_barrier(0);
    __builtin_amdgcn_s_setprio(1);
#pragma unroll
    for (int s = 0; s < 4; s++) {
      bf16x8 af[2], bq[4];
#pragma unroll
      for (int i = 0; i < 2; i++) af[i] = *(const bf16x8*)(sa + (wm * 64 + i * 32 + r) * GS + s * 16 + h * 8);
#pragma unroll
      for (int j = 0; j < 4; j++) bq[j] = *(const bf16x8*)(sb + (wn * 128 + j * 32 + r) * GS + s * 16 + h * 8);
#pragma unroll
      for (int i = 0; i < 2; i++)
#pragma unroll
        for (int j = 0; j < 4; j++) acc[i][j] = MFMA32(bq[j], af[i], acc[i][j]);
    }
    __builtin_amdgcn_s_setprio(0);
  }
  float* Cs = (float*)sa;
#pragma unroll
  for (int hn = 0; hn < 2; hn++) {
    __syncthreads();
    const bool tr = epi.transposed(n0 + hn * 128);
    if (wn == hn) {
#pragma unroll
      for (int i = 0; i < 2; i++)
#pragma unroll
        for (int j = 0; j < 4; j++)
#pragma unroll
          for (int g = 0; g < 4; g++) {
            const int m = wm * 64 + i * 32 + r, n = j * 32 + 8 * g + 4 * h;
            if (!tr) {
              float4 v; v.x = acc[i][j][4 * g]; v.y = acc[i][j][4 * g + 1]; v.z = acc[i][j][4 * g + 2]; v.w = acc[i][j][4 * g + 3];
              *(float4*)(Cs + m * CS + n) = v;
            } else {
              Cs[(n + 0) * CS + m] = acc[i][j][4 * g]; Cs[(n + 1) * CS + m] = acc[i][j][4 * g + 1];
              Cs[(n + 2) * CS + m] = acc[i][j][4 * g + 2]; Cs[(n + 3) * CS + m] = acc[i][j][4 * g + 3];
            }
          }
    }
    __syncthreads();
    epi.store(Cs, m0, n0 + hn * 128);
  }
  __syncthreads();
}

using f32x4v = __attribute__((ext_vector_type(4))) float;
#define MFMA16(a, b, c) __builtin_amdgcn_mfma_f32_16x16x32_bf16((a), (b), (c), 0, 0, 0)
DI int swz(int row, int chunk) { return row * 64 + ((chunk ^ ((row >> 1) & 7)) << 3); }
template <class Epi>
DI void gemm_tile256s(const bf16_t* __restrict__ A, int lda, const bf16_t* __restrict__ Bt, int ldb, int K, int m0, int n0,
                      const Epi& epi, bf16_t* sa, bf16_t* sb) {
  const int tid = get_tid(), lane = tid & 63, w = tid >> 6, lr = lane & 15, q = lane >> 4;
  const int wm = w >> 1, wn = w & 1;
  f32x4v acc[4][8];
#pragma unroll
  for (int i = 0; i < 4; i++)
#pragma unroll
    for (int j = 0; j < 8; j++)
#pragma unroll
      for (int e = 0; e < 4; e++) acc[i][j][e] = 0.f;
  const int lrow = tid >> 3, lch = tid & 7;
  const bf16_t* ga = A + (size_t)(m0 + lrow) * lda + lch * 8;
  const bf16_t* gb = Bt + (size_t)(n0 + lrow) * ldb + lch * 8;
  u32x4 ra[4], rb[8];
  const int nk = K >> 6;
#pragma unroll
  for (int i = 0; i < 4; i++) ra[i] = *(const u32x4*)(ga + (size_t)(32 * i) * lda);
#pragma unroll
  for (int i = 0; i < 8; i++) rb[i] = *(const u32x4*)(gb + (size_t)(32 * i) * ldb);
  for (int kt = 0; kt < nk; kt++) {
    __syncthreads();
#pragma unroll
    for (int i = 0; i < 4; i++) *(u32x4*)(sa + swz(lrow + 32 * i, lch)) = ra[i];
#pragma unroll
    for (int i = 0; i < 8; i++) *(u32x4*)(sb + swz(lrow + 32 * i, lch)) = rb[i];
    __syncthreads();
    {
      const int k0 = (kt + 1 < nk ? kt + 1 : kt) << 6;
#pragma unroll
      for (int i = 0; i < 4; i++) ra[i] = *(const u32x4*)(ga + (size_t)(32 * i) * lda + k0);
#pragma unroll
      for (int i = 0; i < 8; i++) rb[i] = *(const u32x4*)(gb + (size_t)(32 * i) * ldb + k0);
    }
    __builtin_amdgcn_sched_barrier(0);
    __builtin_amdgcn_s_setprio(1);
#pragma unroll
    for (int ks = 0; ks < 2; ks++) {
      bf16x8 af[4], bq[8];
#pragma unroll
      for (int i = 0; i < 4; i++) af[i] = *(const bf16x8*)(sa + swz(wm * 64 + i * 16 + lr, ks * 4 + q));
#pragma unroll
      for (int j = 0; j < 8; j++) bq[j] = *(const bf16x8*)(sb + swz(wn * 128 + j * 16 + lr, ks * 4 + q));
#pragma unroll
      for (int i = 0; i < 4; i++)
#pragma unroll
        for (int j = 0; j < 8; j++) acc[i][j] = MFMA16(bq[j], af[i], acc[i][j]);
    }
    __builtin_amdgcn_s_setprio(0);
  }
  float* Cs = (float*)sa;
#pragma unroll
  for (int hn = 0; hn < 2; hn++) {
    __syncthreads();
    const bool tr = epi.transposed(n0 + hn * 128);
    if (wn == hn) {
#pragma unroll
      for (int i = 0; i < 4; i++)
#pragma unroll
        for (int j = 0; j < 8; j++) {
          const int m = wm * 64 + i * 16 + lr, n = j * 16 + 4 * q;
          if (!tr) {
            float4 v; v.x = acc[i][j][0]; v.y = acc[i][j][1]; v.z = acc[i][j][2]; v.w = acc[i][j][3];
            *(float4*)(Cs + m * CS + n) = v;
          } else {
            Cs[(n + 0) * CS + m] = acc[i][j][0]; Cs[(n + 1) * CS + m] = acc[i][j][1];
            Cs[(n + 2) * CS + m] = acc[i][j][2]; Cs[(n + 3) * CS + m] = acc[i][j][3];
          }
        }
    }
    __syncthreads();
    epi.store(Cs, m0, n0 + hn * 128);
  }
  __syncthreads();
}

template <class Epi>
DI void gemm_phase256(const bf16_t* A, int lda, const bf16_t* Bt, int ldb, int N, int K, const Epi& epi, char* smem) {
  bf16_t* sa = (bf16_t*)smem;
  bf16_t* sb = sa + 128 * GS;
  const int tn = N / 256, tm = (NB * SEQ) / 128;
  const int xcd = blockIdx.x & 7, rank = blockIdx.x >> 3, per = gridDim.x >> 3;
  const int mlo = (xcd * tm) >> 3, mhi = ((xcd + 1) * tm) >> 3, tmx = mhi - mlo;
  for (int L = rank; L < tmx * tn; L += per) {
    const int panel = L / (8 * tn), rem = L - panel * 8 * tn;
    const int nt_ = rem >> 3, mt = mlo + panel * 8 + (rem & 7);
    const int m0 = (mt >> 6) * RB + NCTX + (mt & 63) * 128;
    gemm_tile256s(A, lda, Bt, ldb, K, m0, nt_ * 256, epi, sa, sb);
  }
}

DI void rope_cs(int s_lat, int i, int nfreq, float& cs, float& sn) {
  const int rowp = s_lat >> 6, colp = s_lat & 63;
  const int fi = i < nfreq ? i : i - nfreq;
  const float inv = exp2f(-(float)fi / (float)nfreq * 13.287712379549449f);
  const float ang = (float)(i < nfreq ? rowp : colp) * inv;
  sn = __sinf(ang); cs = __cosf(ang);
}

DI void att_post_phase(const Params& p) {
  const int lane = get_tid() & 63, w = get_tid() >> 6;
  bf16_t* KDA = (bf16_t*)(p.ws + OFF_KDA);
  bf16_t* CQ = (bf16_t*)(p.ws + OFF_CQ);
  bf16_t* CKV = (bf16_t*)(p.ws + OFF_CKV);
  const bf16_t* KR = (const bf16_t*)(p.ws + OFF_KR);
  bf16_t* KMLA = (bf16_t*)(p.ws + OFF_KMLA);
  for (int row = blockIdx.x * 4 + w; row < R; row += gridDim.x * 4) {
    const int b = row_b(row), pos = row - b * RB;
    const bool lat = pos >= NCTX;
    const int s_lat = pos - NCTX;
    if (lat) {
#pragma unroll
      for (int q = 0; q < 4; q++) {
        const int pi = q * 64 + lane, vec = pi >> 5, i = pi & 31;
        bf16_t* kp = KDA + ((size_t)(b * 8 + vec) * RB + pos) * 64;
        float cs, sn; rope_cs(s_lat, i, 16, cs, sn);
        const float x1 = bf2f(kp[i]), x2 = bf2f(kp[i + 32]);
        kp[i] = f2bf(x1 * cs - x2 * sn);
        kp[i + 32] = f2bf(x1 * sn + x2 * cs);
      }
    }
    {
      bf16_t* cq = CQ + (size_t)row * 384;
      float v[6], ss = 0.f;
#pragma unroll
      for (int i = 0; i < 6; i++) { v[i] = bf2f(cq[i * 64 + lane]); ss += v[i] * v[i]; }
      ss = wave_sum(ss);
      const float rstd = rsqrtf(ss * (1.f / 384.f) + EPS);
#pragma unroll
      for (int i = 0; i < 6; i++) cq[i * 64 + lane] = f2bf(v[i] * rstd * p.mla_q_norm[i * 64 + lane]);
    }
    {
      bf16_t* ck = CKV + (size_t)row * 256;
      float v[4], ss = 0.f;
#pragma unroll
      for (int i = 0; i < 4; i++) { v[i] = bf2f(ck[i * 64 + lane]); ss += v[i] * v[i]; }
      ss = wave_sum(ss);
      const float rstd = rsqrtf(ss * (1.f / 256.f) + EPS);
#pragma unroll
      for (int i = 0; i < 4; i++) ck[i * 64 + lane] = f2bf(v[i] * rstd * p.mla_kv_norm[i * 64 + lane]);
    }
    {
      const bf16_t* kr = KR + (size_t)row * 32;
      const int i = lane & 15;
      const float x1 = bf2f(kr[i]), x2 = bf2f(kr[i + 16]);
      float o1 = x1, o2 = x2;
      if (lat) { float cs, sn; rope_cs(s_lat, i, 8, cs, sn); o1 = x1 * cs - x2 * sn; o2 = x1 * sn + x2 * cs; }
      const bf16_t b1 = f2bf(o1), b2 = f2bf(o2);
#pragma unroll
      for (int q = 0; q < 2; q++) {
        const int hh = (lane >> 4) + 4 * q;
        bf16_t* kd = KMLA + ((size_t)(b * 8 + hh) * RB + pos) * 96 + 64;
        kd[i] = b1; kd[i + 16] = b2;
      }
    }
  }
}

template <int DK, int DV>
DI void attn_item(const bf16_t* __restrict__ Q, const bf16_t* __restrict__ Kp, const bf16_t* __restrict__ VT, int ldv, int nkeys,
                  float sc_log2e, int s_lat0  , bf16_t* __restrict__ out, int ostride,
                  char* smem) {
  constexpr int KS = DK + 8;
  constexpr int VS = 68;
  constexpr int NKS = DK / 16;
  constexpr int ND = DV / 32;
  constexpr int KCH = (64 * DK / 8) / 256;
  constexpr int VCH = (DV * 8) / 256;
  constexpr int KBUF = 64 * KS, VBUF = DV * VS;
  bf16_t* sk = (bf16_t*)smem;
  bf16_t* sv = sk + 2 * KBUF;
  const int tid = get_tid(), lane = tid & 63, w = tid >> 6, r = lane & 31, h = lane >> 5;

  bf16x8 qf[NKS];
  const bf16_t* qrow = Q + (size_t)(w * 32 + r) * DK;
#pragma unroll
  for (int s = 0; s < NKS; s++) qf[s] = *(const bf16x8*)(qrow + s * 16 + h * 8);
  if (s_lat0 >= 0) {
    const int s_lat = s_lat0 + w * 32 + r;
    if (DK == 64) {
#pragma unroll
      for (int s = 0; s < 2; s++)
#pragma unroll
        for (int j = 0; j < 8; j++) {
          float cs, sn; rope_cs(s_lat, 16 * s + 8 * h + j, 16, cs, sn);
          const float x1 = bf2f((bf16_t)qf[s][j]), x2 = bf2f((bf16_t)qf[s + 2][j]);
          qf[s][j] = (short)f2bf((x1 * cs - x2 * sn) * sc_log2e);
          qf[s + 2][j] = (short)f2bf((x1 * sn + x2 * cs) * sc_log2e);
        }
    } else {
#pragma unroll
      for (int s = 0; s < NKS - 2; s++)
#pragma unroll
        for (int j = 0; j < 8; j++) qf[s][j] = (short)f2bf(bf2f((bf16_t)qf[s][j]) * sc_log2e);
#pragma unroll
      for (int j = 0; j < 8; j++) {
        float cs, sn; rope_cs(s_lat, 8 * h + j, 8, cs, sn);
        const float x1 = bf2f((bf16_t)qf[NKS - 2][j]), x2 = bf2f((bf16_t)qf[NKS - 1][j]);
        qf[NKS - 2][j] = (short)f2bf((x1 * cs - x2 * sn) * sc_log2e);
        qf[NKS - 1][j] = (short)f2bf((x1 * sn + x2 * cs) * sc_log2e);
      }
    }
  } else {
#pragma unroll
    for (int s = 0; s < NKS; s++)
#pragma unroll
      for (int j = 0; j < 8; j++) qf[s][j] = (short)f2bf(bf2f((bf16_t)qf[s][j]) * sc_log2e);
  }

  f32x16 O[ND];
#pragma unroll
  for (int d = 0; d < ND; d++)
#pragma unroll
    for (int e = 0; e < 16; e++) O[d][e] = 0.f;
  float m_run = 0.f;
  hf2 lsum = {0.f, 0.f};

  u32x4 rkA[KCH], rvA[VCH], rkB[KCH], rvB[VCH];
  auto gload_k = [&](int kt, u32x4* rk) {
#pragma unroll
    for (int i = 0; i < KCH; i++) {
      const int c = tid + 256 * i;
      rk[i] = *(const u32x4*)(Kp + (size_t)kt * 64 * DK + (size_t)c * 8);
    }
  };
  auto gload_v = [&](int kt, u32x4* rv) {
#pragma unroll
    for (int i = 0; i < VCH; i++) {
      const int c = tid + 256 * i, d = c >> 3, cc = c & 7;
      rv[i] = *(const u32x4*)(VT + (size_t)d * ldv + kt * 64 + cc * 8);
    }
  };
  auto stage_k = [&](bf16_t* pk, const u32x4* rk) {
#pragma unroll
    for (int i = 0; i < KCH; i++) {
      const int c = tid + 256 * i, row = c / (DK / 8), cc = c % (DK / 8);
      *(u32x4*)(pk + row * KS + cc * 8) = rk[i];
    }
  };
  auto stage_v = [&](bf16_t* pv, const u32x4* rv) {
#pragma unroll
    for (int i = 0; i < VCH; i++) {
      const int c = tid + 256 * i, d = c >> 3, cc = c & 7;
      u32x2 lo, hi; lo.x = rv[i].x; lo.y = rv[i].y; hi.x = rv[i].z; hi.y = rv[i].w;
      *(u32x2*)(pv + d * VS + cc * 8) = lo;
      *(u32x2*)(pv + d * VS + cc * 8 + 4) = hi;
    }
  };
  f32x16 negm = {0.f, 0.f, 0.f, 0.f, 0.f, 0.f, 0.f, 0.f, 0.f, 0.f, 0.f, 0.f, 0.f, 0.f, 0.f, 0.f};
  bool first = true;
  auto qk = [&](const bf16_t* pk, f32x16* S) {
    bf16x8 kf[2][NKS];
#pragma unroll
    for (int sub = 0; sub < 2; sub++)
#pragma unroll
      for (int s = 0; s < NKS; s++) kf[sub][s] = *(const bf16x8*)(pk + (sub * 32 + r) * KS + s * 16 + h * 8);
    __builtin_amdgcn_sched_barrier(0);
#pragma unroll
    for (int s = 0; s < NKS; s++)
#pragma unroll
      for (int sub = 0; sub < 2; sub++) S[sub] = MFMA32(kf[sub][s], qf[s], s == 0 ? negm : S[sub]);
  };
  const int nt = nkeys >> 6;
  auto vfrag = [&](const bf16_t* pv, int d, int q) -> bf16x8 {
    const bf16_t* vp = pv + (d * 32 + r) * VS + q * 16 + 4 * h;
    const s16x4 lo = *(const s16x4*)vp;
    const s16x4 hi = *(const s16x4*)(vp + 8);
    return __builtin_shufflevector(lo, hi, 0, 1, 2, 3, 4, 5, 6, 7);
  };
  __syncthreads();
  gload_k(0, rkA); gload_v(0, rvA);
  gload_k(1, rkB); gload_v(1, rvB);
  auto tile_body = [&](const bf16_t* pk, const bf16_t* pv) {
    f32x16 S[2];
      qk(pk, S);
      bf16x8 vf[2][4];
#pragma unroll
      for (int q = 0; q < 4; q++) vf[0][q] = vfrag(pv, 0, q);
      __builtin_amdgcn_sched_barrier(0);
      float mx = max3f(S[0][0], S[0][1], S[0][2]);
#pragma unroll
      for (int e = 3; e < 15; e += 2) mx = max3f(mx, S[0][e], S[0][e + 1]);
      mx = max3f(mx, S[0][15], S[1][0]);
#pragma unroll
      for (int e = 1; e < 15; e += 2) mx = max3f(mx, S[1][e], S[1][e + 1]);
      mx = fmaxf(mx, S[1][15]);
      mx = xmax(mx);
      const bool need = first || (mx > 6.0f);
      if (__any(need)) {
        asm volatile("; rare rescale path" ::: "memory");
        const float delta = need ? mx : 0.f;
        const float alpha = first ? 1.f : __builtin_amdgcn_exp2f(-delta);
        m_run += delta;
#pragma unroll
        for (int e = 0; e < 16; e++) negm[e] = -m_run;
#pragma unroll
        for (int sub = 0; sub < 2; sub++)
#pragma unroll
          for (int e = 0; e < 16; e++) S[sub][e] -= delta;
        lsum.x *= alpha;
#pragma unroll
        for (int d = 0; d < ND; d++)
#pragma unroll
          for (int e = 0; e < 16; e++) O[d][e] *= alpha;
      }
      first = false;
#pragma unroll
      for (int sub = 0; sub < 2; sub++)
#pragma unroll
        for (int e = 0; e < 16; e += 2) {
          const float p0 = __builtin_amdgcn_exp2f(S[sub][e]), p1 = __builtin_amdgcn_exp2f(S[sub][e + 1]);
          S[sub][e] = p0; S[sub][e + 1] = p1;
          lsum.x += p0; lsum.x += p1;
        }
      bf16x8 pb[4];
#pragma unroll
      for (int q = 0; q < 4; q++) {
        const int sub = q >> 1, s2 = q & 1;
        u32x4 t;
        t.x = pack2(S[sub][8 * s2 + 0], S[sub][8 * s2 + 1]); t.y = pack2(S[sub][8 * s2 + 2], S[sub][8 * s2 + 3]);
        t.z = pack2(S[sub][8 * s2 + 4], S[sub][8 * s2 + 5]); t.w = pack2(S[sub][8 * s2 + 6], S[sub][8 * s2 + 7]);
        pb[q] = __builtin_bit_cast(bf16x8, t);
      }
      __builtin_amdgcn_s_setprio(1);
#pragma unroll
      for (int d = 0; d < ND; d++) {
        if (d + 1 < ND) {
#pragma unroll
          for (int q = 0; q < 4; q++) vf[(d + 1) & 1][q] = vfrag(pv, d + 1, q);
        }
        __builtin_amdgcn_sched_barrier(0);
#pragma unroll
        for (int q = 0; q < 4; q++) O[d] = MFMA32(vf[d & 1][q], pb[q], O[d]);
      }
      __builtin_amdgcn_s_setprio(0);
  };
  for (int kt = 0; kt < nt; kt += 2) {
    {
      bf16_t* pk = sk; bf16_t* pv = sv;
      stage_k(pk, rkA); stage_v(pv, rvA);
      __syncthreads();
      const int kn = kt + 2 < nt ? kt + 2 : kt;
      gload_k(kn, rkA); gload_v(kn, rvA);
      __builtin_amdgcn_sched_barrier(0);
      tile_body(pk, pv);
    }
    {
      bf16_t* pk = sk + KBUF; bf16_t* pv = sv + VBUF;
      stage_k(pk, rkB); stage_v(pv, rvB);
      __syncthreads();
      const int kn = kt + 3 < nt ? kt + 3 : kt + 1;
      gload_k(kn, rkB); gload_v(kn, rvB);
      __builtin_amdgcn_sched_barrier(0);
      tile_body(pk, pv);
    }
  }
  __syncthreads();
  const float l_run = lsum.x + lsum.y;
  const float lt = xsum(l_run);
  const float inv = 1.f / lt;
  bf16_t* orow = out + (size_t)(w * 32 + r) * ostride;
#pragma unroll
  for (int d = 0; d < ND; d++)
#pragma unroll
    for (int g = 0; g < 4; g++) {
      u32x2 pk2;
      pk2.x = pack2(O[d][4 * g] * inv, O[d][4 * g + 1] * inv);
      pk2.y = pack2(O[d][4 * g + 2] * inv, O[d][4 * g + 3] * inv);
      *(u32x2*)(orow + d * 32 + 8 * g + 4 * h) = pk2;
    }
}

DI void attention_phase(const Params& p, char* smem) {
  const bf16_t* QDA = (const bf16_t*)(p.ws + OFF_QDA);
  const bf16_t* KDA = (const bf16_t*)(p.ws + OFF_KDA);
  const bf16_t* VDAT = (const bf16_t*)(p.ws + OFF_VDAT);
  const bf16_t* QMLA = (const bf16_t*)(p.ws + OFF_QMLA);
  const bf16_t* KMLA = (const bf16_t*)(p.ws + OFF_KMLA);
  const bf16_t* VMLAT = (const bf16_t*)(p.ws + OFF_VMLAT);
  bf16_t* Y = (bf16_t*)(p.ws + OFF_U);
  bf16_t* OA1 = (bf16_t*)(p.ws + OFF_OA1);
  const float da_sc = 0.125f * LOG2E;
  const float mla_sc = 0.10206207261596577f * LOG2E;
  const int xcd = blockIdx.x & 7, rank = blockIdx.x >> 3, per = gridDim.x >> 3;
  const int nlong = (per == 64) ? 4 : 0;
  for (int j = 0; j < nlong + 1 + 2048 / (int)gridDim.x + 1; j++) {
    int it;
    if (j < nlong) it = ((j * 8 + xcd) << 6) + rank;
    else { it = (nlong ? 2048 : 0) + (j - nlong) * gridDim.x + blockIdx.x; }
    if (it >= 2112) break;
    bool da, isctx; int qb, combo;
    if (it < 1024) { da = true; isctx = false; qb = it & 63; combo = it >> 6; }
    else if (it < 2048) { da = false; isctx = false; qb = it & 63; combo = (it - 1024) >> 6; }
    else if (it < 2080) { da = true; isctx = true; qb = it & 1; combo = (it - 2048) >> 1; }
    else { da = false; isctx = true; qb = it & 1; combo = (it - 2080) >> 1; }
    const int pos0 = isctx ? qb * 128 : NCTX + qb * 128;
    const int nkeys = isctx ? NCTX : RB;
    const int s_lat0 = isctx ? -1 : qb * 128;
    if (da) {
      const int hh = combo & 3, m = (combo >> 2) & 1, b = combo >> 3;
      const size_t base = (size_t)((b * 2 + m) * 4 + hh) * RB;
      const size_t grow = (size_t)b * RB + pos0;
      bf16_t* o = m == 0 ? (Y + grow * 1024 + hh * 128) : (OA1 + grow * 512 + hh * 128);
      attn_item<64, 128>(QDA + (base + pos0) * 64, KDA + base * 64, VDAT + (size_t)((b * 4 + hh) * 128) * RB, RB, nkeys, da_sc,
                         s_lat0, o, m == 0 ? 1024 : 512, smem);
    } else {
      const int hh = combo & 7, b = combo >> 3;
      const size_t base = (size_t)(b * 8 + hh) * RB;
      const size_t grow = (size_t)b * RB + pos0;
      attn_item<96, 64>(QMLA + (base + pos0) * 96, KMLA + base * 96, VMLAT + (size_t)((b * 8 + hh) * 64) * RB, RB, nkeys, mla_sc,
                        s_lat0, Y + grow * 1024 + 512 + hh * 64, 1024, smem);
    }
  }
}

DI void da_merge_phase(const Params& p) {
  const int lane = get_tid() & 63, w = get_tid() >> 6;
  bf16_t* Y = (bf16_t*)(p.ws + OFF_U);
  const bf16_t* OA1 = (const bf16_t*)(p.ws + OFF_OA1);
  const float* lp = p.att_lambda;
  const float s1 = wave_sum(lp[lane] * lp[64 + lane]);
  const float s2 = wave_sum(lp[128 + lane] * lp[192 + lane]);
  const float lam_init = 0.2f;
  const float lam = __expf(s1) - __expf(s2) + lam_init;
  float g[8];
#pragma unroll
  for (int j = 0; j < 8; j++) g[j] = p.att_subnorm[(lane & 15) * 8 + j] * (1.f - lam_init);
  for (int row = blockIdx.x * 4 + w; row < R; row += gridDim.x * 4) {
    u32x4 a = *(const u32x4*)(Y + (size_t)row * 1024 + lane * 8);
    u32x4 b4 = *(const u32x4*)(OA1 + (size_t)row * 512 + lane * 8);
    const unsigned au[4] = {a.x, a.y, a.z, a.w}, bu[4] = {b4.x, b4.y, b4.z, b4.w};
    float d[8], ss = 0.f;
#pragma unroll
    for (int j = 0; j < 4; j++) {
      d[2 * j] = bf2f((bf16_t)(au[j] & 0xffff)) - lam * bf2f((bf16_t)(bu[j] & 0xffff));
      d[2 * j + 1] = bf2f((bf16_t)(au[j] >> 16)) - lam * bf2f((bf16_t)(bu[j] >> 16));
      ss += d[2 * j] * d[2 * j] + d[2 * j + 1] * d[2 * j + 1];
    }
#pragma unroll
    for (int o = 8; o >= 1; o >>= 1) ss += __shfl_xor(ss, o, 64);
    const float rstd = rsqrtf(ss * (1.f / 128.f) + EPS);
    u32x4 o4;
    o4.x = pack2(d[0] * rstd * g[0], d[1] * rstd * g[1]);
    o4.y = pack2(d[2] * rstd * g[2], d[3] * rstd * g[3]);
    o4.z = pack2(d[4] * rstd * g[4], d[5] * rstd * g[5]);
    o4.w = pack2(d[6] * rstd * g[6], d[7] * rstd * g[7]);
    *(u32x4*)(Y + (size_t)row * 1024 + lane * 8) = o4;
  }
}

DI void conv_phase(const Params& p) {
  const bf16_t* XBC = (const bf16_t*)(p.ws + OFF_XBC);
  bf16_t* XC = (bf16_t*)(p.ws + OFF_XC);
  const int total = R * 128;
  for (int idx = blockIdx.x * 256 + get_tid(); idx < total; idx += gridDim.x * 256) {
    const int row = idx >> 7, c0 = (idx & 127) * 8;
    const int b = row_b(row), pos = row - b * RB;
    const int lo = pos < NCTX ? 0 : NCTX, hi = pos < NCTX ? NCTX : RB;
    float acc[8];
#pragma unroll
    for (int j = 0; j < 8; j++) acc[j] = p.ssd_conv_b[c0 + j];
#pragma unroll
    for (int t = 0; t < 5; t++) {
      const int pp = pos + t - 2;
      if (pp < lo || pp >= hi) continue;
      const u32x4 xv = *(const u32x4*)(XBC + (size_t)(b * RB + pp) * 1024 + c0);
      const unsigned xu[4] = {xv.x, xv.y, xv.z, xv.w};
      const float* wr = p.ssd_conv_w + t * 1024 + c0;
#pragma unroll
      for (int j = 0; j < 4; j++) {
        acc[2 * j] += wr[2 * j] * bf2f((bf16_t)(xu[j] & 0xffff));
        acc[2 * j + 1] += wr[2 * j + 1] * bf2f((bf16_t)(xu[j] >> 16));
      }
    }
    u32x4 o;
    o.x = pack2(silu_f(acc[0]), silu_f(acc[1])); o.y = pack2(silu_f(acc[2]), silu_f(acc[3]));
    o.z = pack2(silu_f(acc[4]), silu_f(acc[5])); o.w = pack2(silu_f(acc[6]), silu_f(acc[7]));
    *(u32x4*)(XC + (size_t)row * 1024 + c0) = o;
  }
}

DI int scan_pos(int dir, int step) { return dir == 0 ? step : (step < NCTX ? NCTX - 1 - step : RB - 1 - (step - NCTX)); }
constexpr int NCHUNK = RB / 64;
constexpr int TS = 72;
constexpr int QS = 136;

DI void unpack8(const u32x4 v, float* o) {
  o[0] = bf2f((bf16_t)(v.x & 0xffff)); o[1] = bf2f((bf16_t)(v.x >> 16)); o[2] = bf2f((bf16_t)(v.y & 0xffff)); o[3] = bf2f((bf16_t)(v.y >> 16));
  o[4] = bf2f((bf16_t)(v.z & 0xffff)); o[5] = bf2f((bf16_t)(v.z >> 16)); o[6] = bf2f((bf16_t)(v.w & 0xffff)); o[7] = bf2f((bf16_t)(v.w >> 16));
}

template <bool SSD>
struct ScanCtx {
  const bf16_t* P1; const bf16_t* XC; const float* DT;
  int dir, hh, row0, sgn; float A;
  DI size_t row(int t) const { return (size_t)(row0 + sgn * t); }
  DI const bf16_t* lf_ptr(int t, int c8) const { return P1 + row(t) * 3072 + 512 + dir * 512 + hh * 128 + c8; }
  DI const bf16_t* q_ptr(int t, int c8) const { return SSD ? XC + row(t) * 1024 + 768 + (hh >> 2) * 128 + c8 : P1 + row(t) * 3072 + hh * 128 + c8; }
  DI const bf16_t* k_ptr(int t, int c8) const { return XC + row(t) * 1024 + 512 + (hh >> 2) * 128 + c8; }
  DI const bf16_t* v_ptr(int t, int c8) const { return SSD ? XC + row(t) * 1024 + hh * 64 + c8 : P1 + row(t) * 3072 + 1536 + hh * 128 + c8; }
  DI float dt(int t) const { return DT[row(t) * 16 + dir * 8 + hh]; }
};
template <bool SSD>
DI ScanCtx<SSD> make_scan_ctx(const Params& p, int it, int dir) {
  constexpr int NH = SSD ? 8 : 4;
  ScanCtx<SSD> s;
  s.P1 = (const bf16_t*)(p.ws + OFF_P1); s.XC = (const bf16_t*)(p.ws + OFF_XC); s.DT = (const float*)(p.ws + OFF_DT);
  const int c = it % NCHUNK, bh = it / NCHUNK;
  s.hh = bh % NH; const int b = bh / NH;
  s.dir = dir;
  s.row0 = b * RB + scan_pos(dir, c * 64);
  s.sgn = dir ? -1 : 1;
  s.A = SSD ? -__expf(p.ssd_a_log[dir * 8 + s.hh]) : 0.f;
  return s;
}

template <bool SSD>
DI void stage_vt(const ScanCtx<SSD>& cx, bf16_t* VTs, const float* ACdt  , int tid) {
  if (!SSD) {
    const int vg = ((tid >> 6) << 2) | (tid & 3), tq = (tid >> 2) & 15;
    u32x4 raw[4];
#pragma unroll
    for (int i = 0; i < 4; i++) raw[i] = *(const u32x4*)cx.v_ptr(tq * 4 + i, vg * 8);
    float f[4][8];
#pragma unroll
    for (int i = 0; i < 4; i++) unpack8(raw[i], f[i]);
#pragma unroll
    for (int j = 0; j < 8; j++) {
      u32x2 o; o.x = pack2(f[0][j], f[1][j]); o.y = pack2(f[2][j], f[3][j]);
      *(u32x2*)(VTs + (vg * 8 + j) * TS + tq * 4) = o;
    }
  } else {
    const int vg = tid & 7, tq = tid >> 3;
    u32x4 raw[2];
#pragma unroll
    for (int i = 0; i < 2; i++) raw[i] = *(const u32x4*)cx.v_ptr(tq * 2 + i, vg * 8);
    float f[2][8];
#pragma unroll
    for (int i = 0; i < 2; i++) unpack8(raw[i], f[i]);
    const float d0 = ACdt[tq * 2], d1 = ACdt[tq * 2 + 1];
#pragma unroll
    for (int j = 0; j < 8; j++) *(unsigned*)(VTs + (vg * 8 + j) * TS + tq * 2) = pack2(f[0][j] * d0, f[1][j] * d1);
  }
}

template <bool SSD>
DI void ssd_decay(const ScanCtx<SSD>& cx, float* DTs, float* ACs, int tid) {
  if (tid < 64) {
    const float d = cx.dt(tid);
    float a = d * cx.A;
#pragma unroll
    for (int o = 1; o < 64; o <<= 1) { const float n = __shfl_up(a, o, 64); if (tid >= o) a += n; }
    DTs[tid] = d; ACs[tid] = a;
  }
}

DI void hgrn_prefix(const u32x4* lfraw, float lf[4][8], float bc[4][8], float* btot, float* bmid, float* seg  ,
                    float* tot  , float* mid  , int tid) {
  const int kg = ((tid >> 6) << 2) | (tid & 3), tq = (tid >> 2) & 15;
#pragma unroll
  for (int i = 0; i < 4; i++) unpack8(lfraw[i], lf[i]);
#pragma unroll
  for (int j = 0; j < 8; j++) {
    bc[0][j] = lf[0][j]; bc[1][j] = bc[0][j] + lf[1][j]; bc[2][j] = bc[1][j] + lf[2][j]; bc[3][j] = bc[2][j] + lf[3][j];
  }
  {
    float4 a, b; a.x = bc[3][0]; a.y = bc[3][1]; a.z = bc[3][2]; a.w = bc[3][3]; b.x = bc[3][4]; b.y = bc[3][5]; b.z = bc[3][6]; b.w = bc[3][7];
    *(float4*)(seg + tq * 128 + kg * 8) = a; *(float4*)(seg + tq * 128 + kg * 8 + 4) = b;
  }
  __syncthreads();
  if (tid < 128) {
    float run = 0.f;
#pragma unroll
    for (int q = 0; q < 16; q++) {
      const float tmp = seg[q * 128 + tid];
      seg[q * 128 + tid] = run;
      run += tmp;
      if (q == 7) mid[tid] = run;
    }
    tot[tid] = run;
  }
  __syncthreads();
  float base[8];
  {
    const float4 a = *(const float4*)(seg + tq * 128 + kg * 8), b = *(const float4*)(seg + tq * 128 + kg * 8 + 4);
    base[0] = a.x; base[1] = a.y; base[2] = a.z; base[3] = a.w; base[4] = b.x; base[5] = b.y; base[6] = b.z; base[7] = b.w;
    const float4 c = *(const float4*)(tot + kg * 8), d = *(const float4*)(tot + kg * 8 + 4);
    btot[0] = c.x; btot[1] = c.y; btot[2] = c.z; btot[3] = c.w; btot[4] = d.x; btot[5] = d.y; btot[6] = d.z; btot[7] = d.w;
    const float4 e = *(const float4*)(mid + kg * 8), f = *(const float4*)(mid + kg * 8 + 4);
    bmid[0] = e.x; bmid[1] = e.y; bmid[2] = e.z; bmid[3] = e.w; bmid[4] = f.x; bmid[5] = f.y; bmid[6] = f.z; bmid[7] = f.w;
  }
#pragma unroll
  for (int i = 0; i < 4; i++)
#pragma unroll
    for (int j = 0; j < 8; j++) bc[i][j] += base[j];
}

template <bool SSD>
DI void scan_passA(const Params& p, int dir, char* smem) {
  constexpr int V = SSD ? 64 : 128, NH = SSD ? 8 : 4, NIT = 2 * NH * NCHUNK, NKT = SSD ? 2 : 4;
  bf16_t* VTs = (bf16_t*)smem;
  bf16_t* K2T = VTs + 128 * TS;
  float* seg = (float*)(K2T + 128 * TS);
  float* tot = seg + 2048;
  float* mid = tot + 128;
  float* DTs = mid + 128;
  float* ACs = DTs + 64;
  bf16_t* ST = (bf16_t*)(p.ws + (SSD ? OFF_ST2 : OFF_ST));
  float* DEC = (float*)(p.ws + (SSD ? OFF_DEC2 : OFF_DEC));
  const int tid = get_tid(), lane = tid & 63, w = tid >> 6, r = lane & 31, h = lane >> 5;
  const int kg = ((tid >> 6) << 2) | (tid & 3), tq = (tid >> 2) & 15;
  for (int it = blockIdx.x; it < NIT; it += gridDim.x) {
    const ScanCtx<SSD> cx = make_scan_ctx<SSD>(p, it, dir);
    __syncthreads();
    if (!SSD) {
      u32x4 lfraw[4];
#pragma unroll
      for (int i = 0; i < 4; i++) lfraw[i] = *(const u32x4*)cx.lf_ptr(tq * 4 + i, kg * 8);
      stage_vt<SSD>(cx, VTs, nullptr, tid);
      float lf[4][8], bc[4][8], btot[8], bmid[8];
      hgrn_prefix(lfraw, lf, bc, btot, bmid, seg, tot, mid, tid);
#pragma unroll
      for (int j = 0; j < 8; j++) {
        float kv[4];
#pragma unroll
        for (int i = 0; i < 4; i++) kv[i] = (1.f - __expf(lf[i][j])) * __expf(btot[j] - bc[i][j]);
        u32x2 o; o.x = pack2(kv[0], kv[1]); o.y = pack2(kv[2], kv[3]);
        *(u32x2*)(K2T + (kg * 8 + j) * TS + tq * 4) = o;
      }
      if (tq == 0) {
        float4 a, b; a.x = __expf(btot[0]); a.y = __expf(btot[1]); a.z = __expf(btot[2]); a.w = __expf(btot[3]);
        b.x = __expf(btot[4]); b.y = __expf(btot[5]); b.z = __expf(btot[6]); b.w = __expf(btot[7]);
        *(float4*)(DEC + (size_t)it * 128 + kg * 8) = a; *(float4*)(DEC + (size_t)it * 128 + kg * 8 + 4) = b;
      }
    } else {
      u32x4 kraw[4];
#pragma unroll
      for (int i = 0; i < 4; i++) kraw[i] = *(const u32x4*)cx.k_ptr(tq * 4 + i, kg * 8);
      ssd_decay<SSD>(cx, DTs, ACs, tid);
      __syncthreads();
      stage_vt<SSD>(cx, VTs, DTs, tid);
      const float alast = ACs[63];
      float f[4][8], wgt[4];
#pragma unroll
      for (int i = 0; i < 4; i++) { unpack8(kraw[i], f[i]); wgt[i] = __expf(alast - ACs[tq * 4 + i]); }
#pragma unroll
      for (int j = 0; j < 8; j++) {
        u32x2 o; o.x = pack2(f[0][j] * wgt[0], f[1][j] * wgt[1]); o.y = pack2(f[2][j] * wgt[2], f[3][j] * wgt[3]);
        *(u32x2*)(K2T + (kg * 8 + j) * TS + tq * 4) = o;
      }
      if (tid < 128) DEC[(size_t)it * 128 + tid] = __expf(alast);
    }
    __syncthreads();
    const int vs = SSD ? (w & 1) : w, kt0 = SSD ? 2 * (w >> 1) : 0;
    f32x16 acc[NKT];
#pragma unroll
    for (int q = 0; q < NKT; q++)
#pragma unroll
      for (int e = 0; e < 16; e++) acc[q][e] = 0.f;
#pragma unroll
    for (int s = 0; s < 4; s++) {
      const bf16x8 a = *(const bf16x8*)(VTs + (vs * 32 + r) * TS + s * 16 + h * 8);
#pragma unroll
      for (int q = 0; q < NKT; q++) {
        const bf16x8 bb = *(const bf16x8*)(K2T + ((kt0 + q) * 32 + r) * TS + s * 16 + h * 8);
        acc[q] = MFMA32(bb, a, acc[q]);
      }
    }
#pragma unroll
    for (int q = 0; q < NKT; q++)
#pragma unroll
      for (int pp = 0; pp < 2; pp++) {
        const int g0 = 2 * pp, g1 = 2 * pp + 1;
        const unsigned e0 = pack2(acc[q][4 * g0], acc[q][4 * g0 + 1]), e1 = pack2(acc[q][4 * g0 + 2], acc[q][4 * g0 + 3]);
        const unsigned f0 = pack2(acc[q][4 * g1], acc[q][4 * g1 + 1]), f1 = pack2(acc[q][4 * g1 + 2], acc[q][4 * g1 + 3]);
        auto s0 = __builtin_amdgcn_permlane32_swap(e0, f0, false, false);
        auto s1 = __builtin_amdgcn_permlane32_swap(e1, f1, false, false);
        u32x4 o; o.x = s0[0]; o.y = s1[0]; o.z = s0[1]; o.w = s1[1];
        *(u32x4*)(ST + ((size_t)it * V + vs * 32 + r) * 128 + (kt0 + q) * 32 + 16 * pp + 8 * h) = o;
      }
  }
}

template <bool SSD>
DI void scan_passB(const Params& p) {
  constexpr int V = SSD ? 64 : 128, NH = SSD ? 8 : 4;
  constexpr int total = 2 * NH * V * 128;
  bf16_t* ST = (bf16_t*)(p.ws + (SSD ? OFF_ST2 : OFF_ST));
  const float* DEC = (const float*)(p.ws + (SSD ? OFF_DEC2 : OFF_DEC));
  for (int idx = blockIdx.x * 256 + get_tid(); idx < total; idx += gridDim.x * 256) {
    const int k = idx & 127, v = (idx >> 7) % V, bh = idx / (128 * V);
    bf16_t* st = ST + ((size_t)bh * NCHUNK * V + v) * 128 + k;
    const float* dc = DEC + (size_t)bh * NCHUNK * 128 + k;
    float S = 0.f;
    constexpr int G = 44;
    for (int c0 = 0; c0 < NCHUNK; c0 += G) {
      float x[G], d[G];
#pragma unroll
      for (int u = 0; u < G; u++) { x[u] = bf2f(st[(size_t)(c0 + u) * V * 128]); d[u] = dc[(size_t)(c0 + u) * 128]; }
#pragma unroll
      for (int u = 0; u < G; u++) { st[(size_t)(c0 + u) * V * 128] = f2bf(S); S = d[u] * S + x[u]; }
    }
  }
}

template <bool SSD>
DI void scan_passC(const Params& p, int dir, char* smem) {
  constexpr int V = SSD ? 64 : 128, NH = SSD ? 8 : 4, NIT = 2 * NH * NCHUNK;
  bf16_t* Qs = (bf16_t*)smem;
  bf16_t* Ks = Qs + 64 * QS;
  bf16_t* VTs = Ks + 64 * QS;
  bf16_t* Att = VTs + 128 * TS;
  float* seg = (float*)Att;
  float* tot = (float*)(Att + 64 * TS);
  float* mid = tot + 128;
  float* EM = mid + 128;
  float* DTs = EM + 128;
  const bf16_t* ST = (const bf16_t*)(p.ws + (SSD ? OFF_ST2 : OFF_ST));
  bf16_t* U = (bf16_t*)(p.ws + OFF_U);
  const int tid = get_tid(), lane = tid & 63, w = tid >> 6, r = lane & 31, h = lane >> 5;
  const int kg = ((tid >> 6) << 2) | (tid & 3), tq = (tid >> 2) & 15;
  for (int it = blockIdx.x; it < NIT; it += gridDim.x) {
    const ScanCtx<SSD> cx = make_scan_ctx<SSD>(p, it, dir);
    const int cofs = SSD ? 512 + cx.hh * 64 : cx.hh * 128;
    const int vs = SSD ? (w & 1) : w;
    __syncthreads();
    bf16x8 sf[8];
    {
      const bf16_t* sp = ST + ((size_t)it * V + vs * 32 + r) * 128 + h * 8;
#pragma unroll
      for (int s = 0; s < 8; s++) sf[s] = *(const bf16x8*)(sp + s * 16);
    }
    u32x4 qraw[4];
#pragma unroll
    for (int i = 0; i < 4; i++) qraw[i] = *(const u32x4*)cx.q_ptr(tq * 4 + i, kg * 8);
    if (!SSD) {
      u32x4 lfraw[4];
#pragma unroll
      for (int i = 0; i < 4; i++) lfraw[i] = *(const u32x4*)cx.lf_ptr(tq * 4 + i, kg * 8);
      stage_vt<SSD>(cx, VTs, nullptr, tid);
      float lf[4][8], bc[4][8], btot[8], bmid[8];
      hgrn_prefix(lfraw, lf, bc, btot, bmid, seg, tot, mid, tid);
      if (tq == 0) {
#pragma unroll
        for (int j = 0; j < 8; j++) EM[kg * 8 + j] = __expf(bmid[j]);
      }
#pragma unroll
      for (int i = 0; i < 4; i++) {
        float qf_[8], qo[8], ko[8];
        unpack8(qraw[i], qf_);
#pragma unroll
        for (int j = 0; j < 8; j++) {
          const float e = bc[i][j] - bmid[j];
          qo[j] = qf_[j] * __expf(e);
          ko[j] = (1.f - __expf(lf[i][j])) * __expf(-e);
        }
        *(u32x4*)(Qs + (tq * 4 + i) * QS + kg * 8) = pk8(qo);
        *(u32x4*)(Ks + (tq * 4 + i) * QS + kg * 8) = pk8(ko);
      }
    } else {
      u32x4 kraw[4];
#pragma unroll
      for (int i = 0; i < 4; i++) kraw[i] = *(const u32x4*)cx.k_ptr(tq * 4 + i, kg * 8);
      ssd_decay<SSD>(cx, DTs, EM, tid);
      __syncthreads();
      stage_vt<SSD>(cx, VTs, DTs, tid);
#pragma unroll
      for (int i = 0; i < 4; i++) {
        *(u32x4*)(Qs + (tq * 4 + i) * QS + kg * 8) = qraw[i];
        *(u32x4*)(Ks + (tq * 4 + i) * QS + kg * 8) = kraw[i];
      }
    }
    __syncthreads();
    {
      const int ti = w >> 1, si = w & 1;
      f32x16 acc;
#pragma unroll
      for (int e = 0; e < 16; e++) acc[e] = 0.f;
      if (w != 1) {
#pragma unroll
        for (int s = 0; s < 8; s++) {
          const bf16x8 a = *(const bf16x8*)(Qs + (ti * 32 + r) * QS + s * 16 + h * 8);
          const bf16x8 bb = *(const bf16x8*)(Ks + (si * 32 + r) * QS + s * 16 + h * 8);
          acc = MFMA32(bb, a, acc);
        }
      }
      const int t = ti * 32 + r;
      const float act = SSD ? EM[t] : 0.f;
#pragma unroll
      for (int g = 0; g < 4; g++) {
        float vv4[4];
#pragma unroll
        for (int q = 0; q < 4; q++) {
          const int sc = si * 32 + 8 * g + 4 * h + q;
          float val = acc[4 * g + q];
          if (SSD) val *= __expf(fminf(act - EM[sc], 0.f));
          vv4[q] = (sc <= t) ? val : 0.f;
        }
        u32x2 o; o.x = pack2(vv4[0], vv4[1]); o.y = pack2(vv4[2], vv4[3]);
        *(u32x2*)(Att + t * TS + si * 32 + 8 * g + 4 * h) = o;
      }
    }
    __syncthreads();
    {
      if (!SSD) {
#pragma unroll
        for (int s = 0; s < 8; s++)
#pragma unroll
          for (int j = 0; j < 8; j++) sf[s][j] = (short)f2bf(bf2f((bf16_t)sf[s][j]) * EM[s * 16 + h * 8 + j]);
      }
      constexpr int NMT = SSD ? 1 : 2;
#pragma unroll
      for (int mi = 0; mi < NMT; mi++) {
        const int i = SSD ? (w >> 1) : mi;
        f32x16 a1, a2;
#pragma unroll
        for (int e = 0; e < 16; e++) { a1[e] = 0.f; a2[e] = 0.f; }
#pragma unroll
        for (int s = 0; s < 4; s++) {
          const bf16x8 a = *(const bf16x8*)(Att + (i * 32 + r) * TS + s * 16 + h * 8);
          const bf16x8 bb = *(const bf16x8*)(VTs + (vs * 32 + r) * TS + s * 16 + h * 8);
          a1 = MFMA32(bb, a, a1);
        }
#pragma unroll
        for (int s = 0; s < 8; s++) {
          const bf16x8 a = *(const bf16x8*)(Qs + (i * 32 + r) * QS + s * 16 + h * 8);
          a2 = MFMA32(sf[s], a, a2);
        }
        const int t = i * 32 + r;
        const float sc2 = SSD ? __expf(EM[t]) : 1.f;
        bf16_t* orow = U + cx.row(t) * 1024 + cofs + vs * 32;
#pragma unroll
        for (int pp = 0; pp < 2; pp++) {
          float ve[4], vf[4];
#pragma unroll
          for (int q = 0; q < 4; q++) { ve[q] = a1[8 * pp + q] + sc2 * a2[8 * pp + q]; vf[q] = a1[8 * pp + 4 + q] + sc2 * a2[8 * pp + 4 + q]; }
          if (dir) {
            const u32x2 oe = *(const u32x2*)(orow + 16 * pp + 4 * h), of = *(const u32x2*)(orow + 16 * pp + 8 + 4 * h);
            ve[0] += bf2f((bf16_t)(oe.x & 0xffff)); ve[1] += bf2f((bf16_t)(oe.x >> 16));
            ve[2] += bf2f((bf16_t)(oe.y & 0xffff)); ve[3] += bf2f((bf16_t)(oe.y >> 16));
            vf[0] += bf2f((bf16_t)(of.x & 0xffff)); vf[1] += bf2f((bf16_t)(of.x >> 16));
            vf[2] += bf2f((bf16_t)(of.y & 0xffff)); vf[3] += bf2f((bf16_t)(of.y >> 16));
          }
          const unsigned e0 = pack2(ve[0], ve[1]), e1 = pack2(ve[2], ve[3]), f0 = pack2(vf[0], vf[1]), f1 = pack2(vf[2], vf[3]);
          auto s0 = __builtin_amdgcn_permlane32_swap(e0, f0, false, false);
          auto s1 = __builtin_amdgcn_permlane32_swap(e1, f1, false, false);
          u32x4 o; o.x = s0[0]; o.y = s1[0]; o.z = s0[1]; o.w = s1[1];
          *(u32x4*)(orow + 16 * pp + 8 * h) = o;
        }
      }
    }
  }
}

DI void rec_merge_phase(const Params& p) {
  const int lane = get_tid() & 63, w = get_tid() >> 6;
  bf16_t* Y = (bf16_t*)(p.ws + OFF_U);
  const bf16_t* P1 = (const bf16_t*)(p.ws + OFF_P1);
  const bf16_t* XC = (const bf16_t*)(p.ws + OFF_XC);
  const int nrow = NB * SEQ, stride = gridDim.x * 4, c0 = lane * 8;
  auto rowof = [&](int ri) { return (ri >> 13) * RB + NCTX + (ri & (SEQ - 1)); };
  auto loadrow = [&](int row, u32x4* v) {
    v[0] = *(const u32x4*)(Y + (size_t)row * 1024 + c0);
    v[1] = *(const u32x4*)(Y + (size_t)row * 1024 + 512 + c0);
    v[2] = *(const u32x4*)(P1 + (size_t)row * 3072 + 2048 + c0);
    v[3] = *(const u32x4*)(P1 + (size_t)row * 3072 + 2560 + c0);
    v[4] = *(const u32x4*)(XC + (size_t)row * 1024 + c0);
  };
  u32x4 cur[5], nxt[5];
  int ri = blockIdx.x * 4 + w;
  if (ri < nrow) loadrow(rowof(ri), cur);
  for (; ri < nrow; ri += stride) {
    const int row = rowof(ri);
    loadrow(rowof(ri + stride < nrow ? ri + stride : ri), nxt);
    float o[8], g[8], ysum[8], z[8], xs[8];
    unpack8(cur[0], o); unpack8(cur[1], ysum); unpack8(cur[2], g); unpack8(cur[3], z); unpack8(cur[4], xs);
    float ss = 0.f;
#pragma unroll
    for (int j = 0; j < 8; j++) ss += o[j] * o[j];
#pragma unroll
    for (int s = 8; s >= 1; s >>= 1) ss += __shfl_xor(ss, s, 64);
    float rstd = rsqrtf(ss * (1.f / 128.f) + EPS);
    u32x4 o4; unsigned ou[4];
#pragma unroll
    for (int j = 0; j < 4; j++)
      ou[j] = pack2(o[2 * j] * rstd * p.hgrn_out_norm[c0 + 2 * j] * g[2 * j], o[2 * j + 1] * rstd * p.hgrn_out_norm[c0 + 2 * j + 1] * g[2 * j + 1]);
    o4.x = ou[0]; o4.y = ou[1]; o4.z = ou[2]; o4.w = ou[3];
    const float skip = p.ssd_skip[lane >> 3];
    float y[8]; ss = 0.f;
#pragma unroll
    for (int j = 0; j < 8; j++) { y[j] = (ysum[j] + skip * xs[j]) * z[j]; ss += y[j] * y[j]; }
#pragma unroll
    for (int s = 16; s >= 1; s >>= 1) ss += __shfl_xor(ss, s, 64);
    rstd = rsqrtf(ss * (1.f / 256.f) + EPS);
    u32x4 y4;
    y4.x = pack2(y[0] * rstd * p.ssd_norm[c0], y[1] * rstd * p.ssd_norm[c0 + 1]);
    y4.y = pack2(y[2] * rstd * p.ssd_norm[c0 + 2], y[3] * rstd * p.ssd_norm[c0 + 3]);
    y4.z = pack2(y[4] * rstd * p.ssd_norm[c0 + 4], y[5] * rstd * p.ssd_norm[c0 + 5]);
    y4.w = pack2(y[6] * rstd * p.ssd_norm[c0 + 6], y[7] * rstd * p.ssd_norm[c0 + 7]);
    *(u32x4*)(Y + (size_t)row * 1024 + c0) = o4;
    *(u32x4*)(Y + (size_t)row * 1024 + 512 + c0) = y4;
#pragma unroll
    for (int i = 0; i < 5; i++) cur[i] = nxt[i];
  }
}

DI void final_norm_phase(const Params& p) {
  const int lane = get_tid() & 63, w = get_tid() >> 6;
  const int nrow = NB * SEQ, stride = gridDim.x * 4;
  int row = blockIdx.x * 4 + w;
  float4 v[4], vn[4];
  if (row < nrow) {
#pragma unroll
    for (int i = 0; i < 4; i++) v[i] = *(const float4*)(p.out + (size_t)row * 1024 + i * 256 + lane * 4);
  }
  for (; row < nrow; row += stride) {
    float* src = p.out + (size_t)row * 1024;
    {
      const int rn = row + stride < nrow ? row + stride : row;
#pragma unroll
      for (int i = 0; i < 4; i++) vn[i] = *(const float4*)(p.out + (size_t)rn * 1024 + i * 256 + lane * 4);
    }
    float ss = 0.f;
#pragma unroll
    for (int i = 0; i < 4; i++) ss += v[i].x * v[i].x + v[i].y * v[i].y + v[i].z * v[i].z + v[i].w * v[i].w;
    ss = wave_sum(ss);
    const float rstd = rsqrtf(ss * (1.f / 1024.f) + EPS);
#pragma unroll
    for (int i = 0; i < 4; i++) {
      const float4 g = *(const float4*)(p.final_norm + i * 256 + lane * 4);
      float4 o; o.x = v[i].x * rstd * g.x; o.y = v[i].y * rstd * g.y; o.z = v[i].z * rstd * g.z; o.w = v[i].w * rstd * g.w;
      *(float4*)(src + i * 256 + lane * 4) = o;
    }
#pragma unroll
    for (int i = 0; i < 4; i++) v[i] = vn[i];
  }
}

#define XB_TMO      128
#define XB_XCNT(j)  (256  + 64 * (j))
#define XB_XSUB(j)  (1280 + 64 * (j))
#define XB_XGEN(j)  (2304 + 64 * (j))
#define XB_TOP      3328
#define XB_TOPGEN   3392
#define XCD_BAR_WORDS 3456
#define XB_SPIN_CAP (1u << 20)
#define LAS __attribute__((address_space(3)))
DI unsigned xb_ld(unsigned* p) { return __hip_atomic_load(p, __ATOMIC_RELAXED, __HIP_MEMORY_SCOPE_AGENT); }
DI unsigned xb_add(unsigned* p, unsigned v) { return __hip_atomic_fetch_add(p, v, __ATOMIC_RELAXED, __HIP_MEMORY_SCOPE_AGENT); }
DI unsigned xb_xcc_id() { return (unsigned)__builtin_amdgcn_s_getreg((3 << 11) | 20) & 0xFu; }
#define XB_SPIN(cond, bar) do { unsigned _sp = 0; while (cond) { __builtin_amdgcn_s_sleep(1); \
    if ((++_sp & 255u) == 0u) { if (xb_ld(&(bar)[XB_TMO])) break; if (_sp > XB_SPIN_CAP) { atomicAdd(&(bar)[XB_TMO], 1u); break; } } } } while (0)
struct XcdBarrier { unsigned* bar; unsigned x; volatile LAS unsigned* st; };
DI XcdBarrier xcd_barrier_post(unsigned* bar, volatile LAS unsigned* st) {
  XcdBarrier b; b.bar = bar; b.x = xb_xcc_id(); b.st = st;
  if (get_tid() == 0) (void)xb_add(&bar[XB_XCNT(b.x)], 1u);
  return b;
}
DI void xcd_barrier_complete(unsigned* bar, unsigned x, unsigned& nloc, unsigned& nx) {
  const unsigned G = gridDim.x * gridDim.y * gridDim.z;
  unsigned sum, cnt, mine, sp = 0u;
  for (;;) {
    sum = 0u; cnt = 0u; mine = 0u;
#pragma unroll
    for (unsigned j = 0; j < 16; ++j) { const unsigned c = xb_ld(&bar[XB_XCNT(j)]); sum += c; cnt += (c > 0u) ? 1u : 0u; mine = (j == x) ? c : mine; }
    if (sum == G) break;
    __builtin_amdgcn_s_sleep(1);
    if ((++sp & 255u) == 0u) { if (xb_ld(&bar[XB_TMO])) break; if (sp > XB_SPIN_CAP) { atomicAdd(&bar[XB_TMO], 1u); break; } }
  }
  nloc = mine > 0u ? mine : 1u; nx = cnt > 0u ? cnt : 1u;
}
DI void xcd_barrier(const XcdBarrier& b) {
  asm volatile("s_waitcnt vmcnt(0)" ::: "memory");
  __syncthreads();
  if (get_tid() == 0) {
    unsigned* bar = b.bar;
    __builtin_amdgcn_s_waitcnt(0);
    unsigned nloc = b.st[0], nx = b.st[1];
    if (nloc == 0u) { xcd_barrier_complete(bar, b.x, nloc, nx); b.st[0] = nloc; b.st[1] = nx; }
    const unsigned old = xb_add(&bar[XB_XSUB(b.x)], 1u);
    const unsigned gen = old / nloc;
    if (old + 1u == (gen + 1u) * nloc) {
      __builtin_amdgcn_fence(__ATOMIC_RELEASE, "agent");
      asm volatile("s_waitcnt vmcnt(0)" ::: "memory");
      const unsigned og = xb_add(&bar[XB_TOP], 1u);
      const unsigned tg = og / nx;
      if (og + 1u == (tg + 1u) * nx) xb_add(&bar[XB_TOPGEN], 1u);
      else XB_SPIN(xb_ld(&bar[XB_TOPGEN]) == tg, bar);
      __builtin_amdgcn_fence(__ATOMIC_ACQUIRE, "agent");
      xb_add(&bar[XB_XGEN(b.x)], 1u);
      asm volatile("s_waitcnt vmcnt(0)" ::: "memory");
    } else {
      XB_SPIN(xb_ld(&bar[XB_XGEN(b.x)]) == gen, bar);
      __builtin_amdgcn_fence(__ATOMIC_ACQUIRE, "agent");
      asm volatile("s_waitcnt vmcnt(0)" ::: "memory");
    }
  }
  __syncthreads();
}

#ifndef PROBE
#define PROBE 0
#endif
#define GSYNC() do { xcd_barrier(xb); if (PROBE == 1) xcd_barrier(xb); } while (0)
DI void late_transposes(const Params& p, char* smem) {
  char* ws = p.ws;
  transpose_task(p.att_w_out, 1024, 1024, 1024, (bf16_t*)(ws + OFF_WT_ATT_OUT), (float*)smem, 388);
  transpose_task(p.rec_w_in, 1024, REC_IN, REC_IN_PAD, (bf16_t*)(ws + OFF_WT_REC_IN), (float*)smem, 485);
  transpose_task(p.rec_w_out, 1024, 1024, 1024, (bf16_t*)(ws + OFF_WT_REC_OUT), (float*)smem, 70);
  for (int l = 0; l < 2; l++) {
    transpose_task(p.w_mlp_in + (size_t)l * 1024 * 4096, 1024, 4096, 4096, (bf16_t*)(ws + (l ? OFF_WT_MLP_IN1 : OFF_WT_MLP_IN0)), (float*)smem, 167);
    transpose_task(p.w_mlp_out + (size_t)l * 4096 * 1024, 4096, 1024, 1024, (bf16_t*)(ws + (l ? OFF_WT_MLP_OUT1 : OFF_WT_MLP_OUT0)), (float*)smem, 264);
  }
  __syncthreads();
}
constexpr int SMEM_BYTES = 2 * 2 * 128 * GS * 2;
__global__ void __launch_bounds__(256, 2) mega(Params p) {
  __shared__ __attribute__((aligned(16))) char smem[SMEM_BYTES];
  __shared__ __attribute__((aligned(16))) unsigned xb_words[4];
  cg::grid_group grid = cg::this_grid();
  char* ws = p.ws;
  if (get_tid() == 0) { xb_words[0] = 0u; xb_words[1] = 0u; xb_words[2] = 0u; xb_words[3] = 0u; }
  __syncthreads();
  const XcdBarrier xb = xcd_barrier_post((unsigned*)(ws + OFF_BAR), (volatile LAS unsigned*)xb_words);
  if (PROBE == 7 && gridDim.x != 512) { for (int i = 0; i < 400; i++) __builtin_amdgcn_s_sleep(127); }
  if (p.out == nullptr) grid.sync();
  const float* modv = (const float*)(ws + OFF_MODV);
  bf16_t* U = (bf16_t*)(ws + OFF_U);
  float* hctx = (float*)(ws + OFF_HCTX);

  for (int rep = 0; rep < (PROBE == 3 ? 2 : 1); rep++) {
  for (int t = blockIdx.x; t < 384; t += gridDim.x) mod_task(p, t, (float*)smem);
  if (blockIdx.x == gridDim.x - 1) {
    float* LB = (float*)(ws + OFF_LB);
    for (int j = get_tid(); j < 1024; j += 256) LB[j] = sigmoid_f(p.hgrn_bound_logits[1024 + j] - p.hgrn_bound_logits[j]);
  }
  transpose_task(p.att_w_in, 1024, ATT_IN, ATT_IN_PAD, (bf16_t*)(ws + OFF_WT_ATT_IN), (float*)smem, 97);
  transpose_task(p.mla_w_uq, 384, 768, 768, (bf16_t*)(ws + OFF_WT_UQ), (float*)smem, 194);
  transpose_task(p.mla_w_ukv, 256, 1024, 1024, (bf16_t*)(ws + OFF_WT_UKV), (float*)smem, 291, true);
  }
  GSYNC();

  norm_mod_phase(p, 0, 0, true, false);
  if (PROBE == 6) norm_mod_phase(p, 0, 0, true, false);
  GSYNC();
  gemm_phase256(U, 1024, (const bf16_t*)(ws + OFF_WT_ATT_IN), 1024, 2048, 1024, EpiAttIn{ws}, smem);
  gemm_phase(U, 1024, (const bf16_t*)(ws + OFF_WT_ATT_IN), 1024, R, ATT_IN_PAD, 1024, 1, EpiAttIn{ws}, smem, 16);
  gemm_phase(U, 1024, (const bf16_t*)(ws + OFF_WT_ATT_IN), 1024, R, ATT_IN_PAD, 1024, 2, EpiAttIn{ws}, smem);
  GSYNC();
  att_post_phase(p);
  GSYNC();
  gemm_phase((const bf16_t*)(ws + OFF_CQ), 384, (const bf16_t*)(ws + OFF_WT_UQ), 384, R, 768, 384, false, EpiUq{ws}, smem);
  gemm_phase((const bf16_t*)(ws + OFF_CKV), 256, (const bf16_t*)(ws + OFF_WT_UKV), 256, R, 1024, 256, false, EpiUkv{ws}, smem);
  GSYNC();
  if (blockIdx.x < (gridDim.x >> 1)) late_transposes(p, smem);
  attention_phase(p, smem);
  if (blockIdx.x >= (gridDim.x >> 1)) { __syncthreads(); late_transposes(p, smem); }
  if (PROBE == 2) { __syncthreads(); attention_phase(p, smem); }
  GSYNC();
  da_merge_phase(p);
  GSYNC();
  float* ctxp = (float*)(ws + OFF_XC);
  gemm_phase256(U, 1024, (const bf16_t*)(ws + OFF_WT_ATT_OUT), 1024, 1024, 1024, EpiResid{p.x, p.ctx, p.out, hctx, modv, 2, true}, smem);
  gemm_ctx_splitk(U, 1024, (const bf16_t*)(ws + OFF_WT_ATT_OUT), 1024, 1024, ctxp, smem);
  GSYNC();
  norm_mod_phase(p, 0, 1, false, false, ctxp, 0, 2, true);
  if (PROBE == 6) norm_mod_phase(p, 0, 1, false, false);
  GSYNC();
  for (int rep = 0; rep < (PROBE == 4 ? 2 : 1); rep++)
  gemm_phase256(U, 1024, (const bf16_t*)(ws + OFF_WT_MLP_IN0), 1024, 4096, 1024, EpiMlpIn{(bf16_t*)(ws + OFF_HID)}, smem);
  gemm_phase(U, 1024, (const bf16_t*)(ws + OFF_WT_MLP_IN0), 1024, R, 4096, 1024, 2, EpiMlpIn{(bf16_t*)(ws + OFF_HID)}, smem);
  GSYNC();
  gemm_phase256((const bf16_t*)(ws + OFF_HID), 4096, (const bf16_t*)(ws + OFF_WT_MLP_OUT0), 4096, 1024, 4096, EpiResid{p.x, p.ctx, p.out, hctx, modv, 5, false}, smem);
  gemm_ctx_splitk((const bf16_t*)(ws + OFF_HID), 4096, (const bf16_t*)(ws + OFF_WT_MLP_OUT0), 4096, 4096, ctxp, smem);
  GSYNC();

  norm_mod_phase(p, 1, 0, false, false, ctxp, 0, 5);
  if (PROBE == 6) norm_mod_phase(p, 1, 0, false, false);
  GSYNC();
  gemm_phase256(U, 1024, (const bf16_t*)(ws + OFF_WT_REC_IN), 1024, 4096, 1024, EpiRecIn{ws, p.ssd_dt_bias}, smem);
  gemm_phase(U, 1024, (const bf16_t*)(ws + OFF_WT_REC_IN), 1024, R, REC_IN_PAD, 1024, 1, EpiRecIn{ws, p.ssd_dt_bias}, smem, 32);
  gemm_phase(U, 1024, (const bf16_t*)(ws + OFF_WT_REC_IN), 1024, R, REC_IN_PAD, 1024, 2, EpiRecIn{ws, p.ssd_dt_bias}, smem);
  GSYNC();
  conv_phase(p);
  if (PROBE == 6) conv_phase(p);
  GSYNC();
  scan_passA<false>(p, 0, smem); GSYNC();
  scan_passB<false>(p); scan_passA<true>(p, 0, smem); GSYNC();
  scan_passC<false>(p, 0, smem); scan_passB<true>(p); GSYNC();
  scan_passA<false>(p, 1, smem); scan_passC<true>(p, 0, smem); GSYNC();
  scan_passB<false>(p); scan_passA<true>(p, 1, smem); GSYNC();
  scan_passC<false>(p, 1, smem); scan_passB<true>(p); GSYNC();
  scan_passC<true>(p, 1, smem); GSYNC();
  rec_merge_phase(p);
  GSYNC();
  gemm_phase256(U, 1024, (const bf16_t*)(ws + OFF_WT_REC_OUT), 1024, 1024, 1024, EpiResid{p.x, p.ctx, p.out, hctx, modv + 3 * 6144, 2, false}, smem);
  GSYNC();
  norm_mod_phase(p, 1, 1, false, true);
  if (PROBE == 6) norm_mod_phase(p, 1, 1, false, true);
  GSYNC();
  gemm_phase256(U, 1024, (const bf16_t*)(ws + OFF_WT_MLP_IN1), 1024, 4096, 1024, EpiMlpIn{(bf16_t*)(ws + OFF_HID)}, smem);
  GSYNC();
  gemm_phase256((const bf16_t*)(ws + OFF_HID), 4096, (const bf16_t*)(ws + OFF_WT_MLP_OUT1), 4096, 1024, 4096, EpiResid{p.x, p.ctx, p.out, hctx, modv + 3 * 6144, 5, false}, smem);
  GSYNC();
  final_norm_phase(p);
}

extern "C" void kernel_launch(void* const* d_in, const int* in_sizes, int n_in, void* d_out, int out_size, void* d_ws, size_t ws_size,
                              hipStream_t stream) {
  static int grid_blocks = 0;
  if (!grid_blocks) {
    int dev = 0, cus = 0, per_cu = 0;
    hipGetDevice(&dev);
    hipDeviceGetAttribute(&cus, hipDeviceAttributeMultiprocessorCount, dev);
    hipOccupancyMaxActiveBlocksPerMultiprocessor(&per_cu, mega, 256, 0);
    if (per_cu < 1) per_cu = 1;
    if (per_cu > 2) per_cu = 2;
    grid_blocks = cus * per_cu;
  }
  Params p{};
  const float** f = (const float**)&p;
  for (int i = 0; i < 29; i++) f[i] = (const float*)d_in[i];
  p.out = (float*)d_out;
  p.ws = (char*)d_ws;
  hipMemsetAsync((char*)d_ws + OFF_BAR, 0, XCD_BAR_WORDS * 4, stream);
  void* args[] = {&p};
  hipError_t e = hipLaunchCooperativeKernel((void*)mega, dim3(grid_blocks), dim3(256), args, 0, stream);
  if (e != hipSuccess) fprintf(stderr, "cooperative launch failed: %s (grid %d)\n", hipGetErrorString(e), grid_blocks);
}
```

```cpp
#include <hip/hip_runtime.h>
#include <hip/hip_cooperative_groups.h>
#include <cstdio>
namespace cg = cooperative_groups;

typedef unsigned short bf16_t;
using bf16x8 = __attribute__((ext_vector_type(8))) short;
using s16x4  = __attribute__((ext_vector_type(4))) short;
using f32x16 = __attribute__((ext_vector_type(16))) float;
using u32x4 = __attribute__((ext_vector_type(4))) unsigned;
using f32x4nt = __attribute__((ext_vector_type(4))) float;
using u32x2 = __attribute__((ext_vector_type(2))) unsigned;
#define DI __device__ __forceinline__
#define MFMA32(a, b, c) __builtin_amdgcn_mfma_f32_32x32x16_bf16((a), (b), (c), 0, 0, 0)

constexpr int D = 1024, NB = 2, SEQ = 8192, NCTX = 256;
constexpr int RB = NCTX + SEQ;
constexpr int R = NB * RB;
constexpr int ATT_IN = 2208, ATT_IN_PAD = 2304;
constexpr int REC_IN = 4112, REC_IN_PAD = 4224;
constexpr int HID = 4096;
constexpr float EPS = 1e-6f;
constexpr float LOG2E = 1.4426950408889634f;

constexpr size_t SZ_WT_ATT_IN = (size_t)ATT_IN_PAD * 1024 * 2;
constexpr size_t SZ_WT_UQ = (size_t)768 * 384 * 2;
constexpr size_t SZ_WT_UKV = (size_t)1024 * 256 * 2;
constexpr size_t SZ_WT_SQ = (size_t)1024 * 1024 * 2;
constexpr size_t SZ_WT_REC_IN = (size_t)REC_IN_PAD * 1024 * 2;
constexpr size_t SZ_WT_MLP = (size_t)2 * 4096 * 1024 * 2;
constexpr size_t SZ_WT_MLP1 = (size_t)4096 * 1024 * 2;
constexpr size_t OFF_WT_REC_OUT = 0;
constexpr size_t OFF_WT_MLP_IN1 = OFF_WT_REC_OUT + SZ_WT_SQ;
constexpr size_t OFF_WT_MLP_OUT1 = OFF_WT_MLP_IN1 + SZ_WT_MLP1;
constexpr size_t OFF_U = OFF_WT_MLP_OUT1 + SZ_WT_MLP1;
constexpr size_t SZ_U = (size_t)R * 1024 * 2;
constexpr size_t OFF_MODV = OFF_U + SZ_U;
constexpr size_t SZ_MODV = (size_t)2 * 3 * 6144 * 4;
constexpr size_t OFF_LB = OFF_MODV + SZ_MODV;
constexpr size_t OFF_HCTX = OFF_LB + 4096;
constexpr size_t SZ_HCTX = (size_t)NB * NCTX * 1024 * 4;
constexpr size_t OFF_DT = OFF_HCTX + SZ_HCTX;
constexpr size_t SZ_DT = (size_t)R * 16 * 4;
constexpr size_t OFF_BIG = OFF_DT + SZ_DT;
constexpr size_t SZ_R512 = (size_t)R * 512 * 2;
constexpr size_t OFF_QDA = OFF_BIG;
constexpr size_t OFF_KDA = OFF_QDA + SZ_R512;
constexpr size_t OFF_VDAT = OFF_KDA + SZ_R512;
constexpr size_t OFF_CQ = OFF_VDAT + SZ_R512;
constexpr size_t OFF_CKV = OFF_CQ + (size_t)R * 384 * 2;
constexpr size_t OFF_KR = OFF_CKV + (size_t)R * 256 * 2;
constexpr size_t OFF_QMLA = OFF_KR + (size_t)R * 32 * 2;
constexpr size_t OFF_KMLA = OFF_QMLA + (size_t)R * 768 * 2;
constexpr size_t OFF_VMLAT = OFF_KMLA + (size_t)R * 768 * 2;
constexpr size_t OFF_OA1 = OFF_VMLAT + SZ_R512;
constexpr size_t OFF_P1 = OFF_BIG;
constexpr size_t OFF_XBC = OFF_P1 + (size_t)R * 3072 * 2;
constexpr size_t OFF_ST = OFF_XBC;
constexpr size_t OFF_XC = OFF_XBC + (size_t)R * 1024 * 2;
constexpr size_t OFF_DEC = OFF_XC + (size_t)R * 1024 * 2;
constexpr size_t OFF_DEC2 = OFF_DEC + (size_t)1056 * 128 * 4;
constexpr size_t OFF_TAIL = (OFF_DEC2 + (size_t)2112 * 128 * 4 + 255) / 256 * 256;
constexpr size_t OFF_WT_ATT_IN = OFF_TAIL;
constexpr size_t OFF_WT_UQ = OFF_WT_ATT_IN + SZ_WT_ATT_IN;
constexpr size_t OFF_WT_UKV = OFF_WT_UQ + SZ_WT_UQ;
constexpr size_t OFF_WT_ATT_OUT = OFF_WT_UKV + SZ_WT_UKV;
constexpr size_t OFF_WT_REC_IN = OFF_WT_ATT_OUT + SZ_WT_SQ;
constexpr size_t OFF_WT_MLP_IN0 = OFF_WT_REC_IN + SZ_WT_REC_IN;
constexpr size_t OFF_WT_MLP_OUT0 = OFF_WT_MLP_IN0 + SZ_WT_MLP1;
constexpr size_t OFF_END = OFF_WT_MLP_OUT0 + SZ_WT_MLP1;
constexpr size_t OFF_ST2 = OFF_TAIL;
constexpr size_t OFF_HID = OFF_BIG;
constexpr size_t OFF_BAR = (size_t)256 * 1024 * 1024 - 16384;
static_assert(OFF_END <= OFF_BAR, "workspace overflow");
static_assert(OFF_ST2 + (size_t)2112 * 64 * 128 * 2 <= OFF_BAR, "SSD state buffer does not fit behind the dead-weights tail");
static_assert(OFF_OA1 + SZ_R512 <= OFF_END, "layer0 overflow");

struct Params {
  const float *x, *c, *ctx, *c_ctx, *w_mod, *b_mod, *norm_mix, *norm_mlp, *w_mlp_in, *w_mlp_out;
  const float *att_w_in, *att_lambda, *att_subnorm, *mla_q_norm, *mla_w_uq, *mla_kv_norm, *mla_w_ukv, *att_w_out;
  const float *rec_w_in, *hgrn_bound_logits, *hgrn_out_norm, *ssd_conv_w, *ssd_conv_b, *ssd_a_log, *ssd_dt_bias;
  const float *ssd_skip, *ssd_norm, *rec_w_out, *final_norm;
  float* out;
  char* ws;
};

DI int get_tid() { int t = threadIdx.x; asm volatile("" : "+v"(t)); return t; }
DI float bf2f(bf16_t u) { return __uint_as_float(((unsigned)u) << 16); }
typedef __bf16 hbf2 __attribute__((ext_vector_type(2)));
typedef float hf2 __attribute__((ext_vector_type(2)));
DI bf16_t f2bf(float x) { __bf16 b = (__bf16)x; return __builtin_bit_cast(unsigned short, b); }
DI unsigned pack2(float a, float b) { hf2 v = {a, b}; hbf2 r = __builtin_convertvector(v, hbf2); return __builtin_bit_cast(unsigned, r); }
DI float max3f(float a, float b, float c) { float r; asm("v_max3_f32 %0, %1, %2, %3" : "=v"(r) : "v"(a), "v"(b), "v"(c)); return r; }
DI float xmax(float x) {
  const unsigned u = __float_as_uint(x);
  auto rr = __builtin_amdgcn_permlane32_swap(u, u, false, false);
  return fmaxf(__uint_as_float(rr[0]), __uint_as_float(rr[1]));
}
DI float xsum(float x) {
  const unsigned u = __float_as_uint(x);
  auto rr = __builtin_amdgcn_permlane32_swap(u, u, false, false);
  return __uint_as_float(rr[0]) + __uint_as_float(rr[1]);
}
DI float silu_f(float x) { return x / (1.f + __expf(-x)); }
DI float sigmoid_f(float x) { return 1.f / (1.f + __expf(-x)); }
DI float wave_sum(float v) {
#pragma unroll
  for (int o = 32; o >= 1; o >>= 1) v += __shfl_xor(v, o, 64);
  return v;
}
DI int row_b(int row) { return row >= RB ? 1 : 0; }

DI void transpose_task(const float* __restrict__ src, int K, int N, int Npad, bf16_t* __restrict__ dst, float* tile, int rot, bool ukv_perm = false) {
  const int tid = get_tid();
  const int tk = K / 64, tn = Npad / 64, ntile = tk * tn;
  const int nb = gridDim.x;
  for (int t0 = (blockIdx.x + rot) % nb; t0 < ntile; t0 += 2 * nb) {
    float4 v[2][4];
#pragma unroll
    for (int u = 0; u < 2; u++) {
      const int t = t0 + u * nb;
      if (t < ntile) {
        const int k0 = (t % tk) * 64, n0 = (t / tk) * 64;
#pragma unroll
        for (int i = 0; i < 4; i++) {
          const int c = tid + 256 * i, kk = c >> 4, n4 = (c & 15) * 4;
          const int n = n0 + n4;
          const float* sp = src + (size_t)(k0 + kk) * N + n;
          if (n + 3 < N) { const f32x4nt t4 = __builtin_nontemporal_load((const f32x4nt*)sp); v[u][i].x = t4[0]; v[u][i].y = t4[1]; v[u][i].z = t4[2]; v[u][i].w = t4[3]; }
          else { v[u][i].x = n < N ? sp[0] : 0.f; v[u][i].y = n + 1 < N ? sp[1] : 0.f; v[u][i].z = n + 2 < N ? sp[2] : 0.f; v[u][i].w = 0.f; }
        }
      }
    }
    __syncthreads();
#pragma unroll
    for (int u = 0; u < 2; u++)
#pragma unroll
      for (int i = 0; i < 4; i++) {
        const int c = tid + 256 * i, kk = c >> 4, n4 = (c & 15) * 4;
        float* tp = tile + u * (64 * 65) + kk * 65 + n4;
        tp[0] = v[u][i].x; tp[1] = v[u][i].y; tp[2] = v[u][i].z; tp[3] = v[u][i].w;
      }
    __syncthreads();
#pragma unroll
    for (int u = 0; u < 2; u++) {
      const int t = t0 + u * nb;
      if (t < ntile) {
        const int k0 = (t % tk) * 64, n0 = (t / tk) * 64;
#pragma unroll
        for (int i = 0; i < 2; i++) {
          const int c = tid + 256 * i, nn = c >> 3, kc = (c & 7) * 8;
          const float* tp = tile + u * (64 * 65) + kc * 65 + nn;
          u32x4 o;
          o.x = pack2(tp[0], tp[65]); o.y = pack2(tp[130], tp[195]); o.z = pack2(tp[260], tp[325]); o.w = pack2(tp[390], tp[455]);
          int nd = n0 + nn;
          if (ukv_perm) { const int e = nd & 127, hh = nd >> 7; nd = e < 64 ? hh * 64 + e : 512 + hh * 64 + (e - 64); }
          __builtin_nontemporal_store(o, (u32x4*)(dst + (size_t)nd * K + k0 + kc));
        }
      }
    }
  }
}

DI void mod_task(const Params& p, int t, float* sm) {
  const int tid = get_tid();
  float* sv = sm;
  float* red = sm + 3072;
  const int l = t / 192, n0 = (t % 192) * 32;
  __syncthreads();
  for (int i = tid; i < 3072; i += 256) {
    int which = i >> 10, k = i & 1023;
    float v = which == 0 ? p.c[k] : (which == 1 ? p.c[1024 + k] : p.c_ctx[k]);
    sv[i] = silu_f(v);
  }
  __syncthreads();
  const int col = tid & 31, kq = tid >> 5;
  const float* w = p.w_mod + (size_t)l * 1024 * 6144 + n0 + col;
  float a0 = 0.f, a1 = 0.f, a2 = 0.f;
#pragma unroll 32
  for (int k = kq * 128; k < kq * 128 + 128; k++) {
    float wv = w[(size_t)k * 6144];
    a0 += sv[k] * wv; a1 += sv[1024 + k] * wv; a2 += sv[2048 + k] * wv;
  }
  red[(kq * 3 + 0) * 32 + col] = a0; red[(kq * 3 + 1) * 32 + col] = a1; red[(kq * 3 + 2) * 32 + col] = a2;
  __syncthreads();
  if (tid < 96) {
    int i = tid >> 5, cc = tid & 31;
    float sacc = p.b_mod[l * 6144 + n0 + cc];
    for (int q = 0; q < 8; q++) sacc += red[(q * 3 + i) * 32 + cc];
    float* modv = (float*)(p.ws + OFF_MODV);
    modv[(l * 3 + i) * 6144 + n0 + cc] = sacc;
  }
}

DI void norm_mod_phase(const Params& p, int l, int which, bool from_input, bool lat_only, const float* ctxp = nullptr, int padd_l = 0, int padd_g = 0, bool ctx_base_input = false) {
  const int lane = get_tid() & 63, w = get_tid() >> 6;
  const float* modv = (const float*)(p.ws + OFF_MODV);
  const float* gain = (which == 0 ? p.norm_mix : p.norm_mlp) + l * 1024;
  bf16_t* U = (bf16_t*)(p.ws + OFF_U);
  const float* hctx = (const float*)(p.ws + OFF_HCTX);
  const int nrow = lat_only ? NB * SEQ : R, stride = gridDim.x * 4;
  auto rowof = [&](int ri) { return lat_only ? (ri >> 13) * RB + NCTX + (ri & (SEQ - 1)) : ri; };
  auto srcof = [&](int row) -> const float* {
    const int b = row_b(row), pos = row - b * RB;
    if (pos < NCTX) return ((from_input || ctx_base_input) ? p.ctx : hctx) + (size_t)(b * NCTX + pos) * 1024;
    return (from_input ? p.x : (const float*)p.out) + (size_t)(b * SEQ + pos - NCTX) * 1024;
  };
  int ri = blockIdx.x * 4 + w;
  float4 v[4], vn[4];
  if (ri < nrow) {
    const float* src = srcof(rowof(ri));
#pragma unroll
    for (int i = 0; i < 4; i++) v[i] = *(const float4*)(src + i * 256 + lane * 4);
  }
  for (; ri < nrow; ri += stride) {
    const int row = rowof(ri);
    {
      const int rn = ri + stride < nrow ? ri + stride : ri;
      const float* srcn = srcof(rowof(rn));
#pragma unroll
      for (int i = 0; i < 4; i++) vn[i] = *(const float4*)(srcn + i * 256 + lane * 4);
    }
    const int b = row_b(row), pos = row - b * RB;
    const bool isctx = pos < NCTX;
    const float* mv = modv + (size_t)(l * 3 + (isctx ? 2 : b)) * 6144;
    const float* shift = mv + (which ? 3 : 0) * 1024;
    const float* scale = mv + (which ? 4 : 1) * 1024;
    if (ctxp != nullptr && isctx) {
      const float* gate = modv + (size_t)(padd_l * 3 + 2) * 6144 + padd_g * 1024;
      const size_t crow = (size_t)(b * NCTX + pos);
      float* hc = (float*)(p.ws + OFF_HCTX) + crow * 1024;
#pragma unroll
      for (int i = 0; i < 4; i++) {
        const int cidx = i * 256 + lane * 4;
        float4 acc = *(const float4*)(ctxp + crow * 1024 + cidx);
#pragma unroll
        for (int q = 1; q < 4; q++) {
          const float4 t = *(const float4*)(ctxp + ((size_t)q * (NB * NCTX) + crow) * 1024 + cidx);
          acc.x += t.x; acc.y += t.y; acc.z += t.z; acc.w += t.w;
        }
        const float4 g4 = *(const float4*)(gate + cidx);
        v[i].x += g4.x * acc.x; v[i].y += g4.y * acc.y; v[i].z += g4.z * acc.z; v[i].w += g4.w * acc.w;
        *(float4*)(hc + cidx) = v[i];
      }
    }
    float ss = 0.f;
#pragma unroll
    for (int i = 0; i < 4; i++) ss += v[i].x * v[i].x + v[i].y * v[i].y + v[i].z * v[i].z + v[i].w * v[i].w;
    ss = wave_sum(ss);
    const float rstd = rsqrtf(ss * (1.f / 1024.f) + EPS);
#pragma unroll
    for (int i = 0; i < 4; i++) {
      int cidx = i * 256 + lane * 4;
      float4 g = *(const float4*)(gain + cidx), sh = *(const float4*)(shift + cidx), sc = *(const float4*)(scale + cidx);
      float o0 = v[i].x * rstd * g.x * (1.f + sc.x) + sh.x;
      float o1 = v[i].y * rstd * g.y * (1.f + sc.y) + sh.y;
      float o2 = v[i].z * rstd * g.z * (1.f + sc.z) + sh.z;
      float o3 = v[i].w * rstd * g.w * (1.f + sc.w) + sh.w;
      u32x2 pk; pk.x = pack2(o0, o1); pk.y = pack2(o2, o3);
      *(u32x2*)(U + (size_t)row * 1024 + cidx) = pk;
    }
#pragma unroll
    for (int i = 0; i < 4; i++) v[i] = vn[i];
  }
}

constexpr int CS = 132;
constexpr int GS = 72;
template <class Epi>
DI void gemm_tile(const bf16_t* __restrict__ A, int lda, const bf16_t* __restrict__ Bt, int ldb, int K, int m0, int n0,
                  const Epi& epi, bf16_t* sa, bf16_t* sb) {
  const int tid = get_tid(), lane = tid & 63, w = tid >> 6, r = lane & 31, h = lane >> 5;
  const int wm = w >> 1, wn = w & 1;
  f32x16 acc[2][2];
#pragma unroll
  for (int i = 0; i < 2; i++)
#pragma unroll
    for (int j = 0; j < 2; j++)
#pragma unroll
      for (int e = 0; e < 16; e++) acc[i][j][e] = 0.f;
  const int lrow = tid >> 3, lc = (tid & 7) * 8;
  const bf16_t* ga = A + (size_t)(m0 + lrow) * lda + lc;
  const bf16_t* gb = Bt + (size_t)(n0 + lrow) * ldb + lc;
  u32x4 ra[4], rb[4];
  const int nk = K >> 6;
#pragma unroll
  for (int i = 0; i < 4; i++) {
    ra[i] = *(const u32x4*)(ga + (size_t)(32 * i) * lda);
    rb[i] = *(const u32x4*)(gb + (size_t)(32 * i) * ldb);
  }
  for (int kt = 0; kt < nk; kt++) {
    bf16_t* pa = sa + (kt & 1) * (128 * GS);
    bf16_t* pb = sb + (kt & 1) * (128 * GS);
#pragma unroll
    for (int i = 0; i < 4; i++) {
      *(u32x4*)(pa + (lrow + 32 * i) * GS + lc) = ra[i];
      *(u32x4*)(pb + (lrow + 32 * i) * GS + lc) = rb[i];
    }
    __syncthreads();
    {
      const int k0 = (kt + 1 < nk ? kt + 1 : kt) << 6;
#pragma unroll
      for (int i = 0; i < 4; i++) {
        ra[i] = *(const u32x4*)(ga + (size_t)(32 * i) * lda + k0);
        rb[i] = *(const u32x4*)(gb + (size_t)(32 * i) * ldb + k0);
      }
    }
    __builtin_amdgcn_sched_barrier(0);
#pragma unroll
    for (int s = 0; s < 4; s++) {
      bf16x8 af[2], bq[2];
#pragma unroll
      for (int i = 0; i < 2; i++) af[i] = *(const bf16x8*)(pa + (wm * 64 + i * 32 + r) * GS + s * 16 + h * 8);
#pragma unroll
      for (int j = 0; j < 2; j++) bq[j] = *(const bf16x8*)(pb + (wn * 64 + j * 32 + r) * GS + s * 16 + h * 8);
#pragma unroll
      for (int i = 0; i < 2; i++)
#pragma unroll
        for (int j = 0; j < 2; j++) acc[i][j] = MFMA32(bq[j], af[i], acc[i][j]);
    }
  }
  __syncthreads();
  float* Cs = (float*)sa;
  const bool tr = epi.transposed(n0);
#pragma unroll
  for (int i = 0; i < 2; i++)
#pragma unroll
    for (int j = 0; j < 2; j++)
#pragma unroll
      for (int g = 0; g < 4; g++) {
        const int m = wm * 64 + i * 32 + r, n = wn * 64 + j * 32 + 8 * g + 4 * h;
        if (!tr) {
          float4 v; v.x = acc[i][j][4 * g]; v.y = acc[i][j][4 * g + 1]; v.z = acc[i][j][4 * g + 2]; v.w = acc[i][j][4 * g + 3];
          *(float4*)(Cs + m * CS + n) = v;
        } else {
          Cs[(n + 0) * CS + m] = acc[i][j][4 * g]; Cs[(n + 1) * CS + m] = acc[i][j][4 * g + 1];
          Cs[(n + 2) * CS + m] = acc[i][j][4 * g + 2]; Cs[(n + 3) * CS + m] = acc[i][j][4 * g + 3];
        }
      }
  __syncthreads();
  epi.store(Cs, m0, n0);
  __syncthreads();
}

template <class Epi>
DI void gemm_phase(const bf16_t* A, int lda, const bf16_t* Bt, int ldb, int M, int Npad, int K, int mode  , const Epi& epi,
                   char* smem, int ntile_lo = 0) {
  bf16_t* sa = (bf16_t*)smem;
  bf16_t* sb = sa + 2 * 128 * GS;
  const int tn = Npad / 128 - ntile_lo, tm = mode == 1 ? (NB * SEQ) / 128 : (mode == 2 ? (NB * NCTX) / 128 : M / 128);
  const int xcd = blockIdx.x & 7, rank = blockIdx.x >> 3, per = gridDim.x >> 3;
  const int mlo = (xcd * tm) >> 3, mhi = ((xcd + 1) * tm) >> 3, tmx = mhi - mlo;
  const int full = tmx >> 3, nfull = full * 8 * tn;
  for (int L = rank; L < tmx * tn; L += per) {
    int mt, nt_;
    if (L < nfull) { const int panel = L / (8 * tn), rem = L - panel * 8 * tn; nt_ = rem >> 3; mt = mlo + panel * 8 + (rem & 7); }
    else { const int rem = L - nfull, ph = tmx - full * 8; nt_ = rem / ph; mt = mlo + full * 8 + (rem - nt_ * ph); }
    const int n0 = (nt_ + ntile_lo) * 128;
    const int m0 = mode == 1 ? (mt >> 6) * RB + NCTX + (mt & 63) * 128 : (mode == 2 ? (mt >> 1) * RB + (mt & 1) * 128 : mt * 128);
    gemm_tile(A, lda, Bt, ldb, K, m0, n0, epi, sa, sb);
  }
}

DI void ld8f(const float* p, float* o) {
  const float4 a = *(const float4*)p, b = *(const float4*)(p + 4);
  o[0] = a.x; o[1] = a.y; o[2] = a.z; o[3] = a.w; o[4] = b.x; o[5] = b.y; o[6] = b.z; o[7] = b.w;
}
DI u32x4 pk8(const float* v) { u32x4 o; o.x = pack2(v[0], v[1]); o.y = pack2(v[2], v[3]); o.z = pack2(v[4], v[5]); o.w = pack2(v[6], v[7]); return o; }

struct EpiAttIn {
  char* ws;
  DI bool transposed(int n0) const { return n0 >= 1024 && n0 < 1536; }
  DI void store(const float* Cs, int m0, int n0) const {
    const int tid = get_tid();
    const int b = row_b(m0), pos0 = m0 - b * RB;
#pragma unroll 2
    for (int i = 0; i < 8; i++) {
      const int c = tid + 256 * i, row = c >> 4, ch = c & 15;
      float v[8]; ld8f(Cs + row * CS + ch * 8, v);
      const u32x4 o = pk8(v);
      if (n0 < 1024) {
        const int hh = (n0 & 511) >> 7, m = ch >> 3, d0 = (ch & 7) * 8;
        bf16_t* dst = (bf16_t*)(ws + (n0 < 512 ? OFF_QDA : OFF_KDA)) + ((size_t)((b * 2 + m) * 4 + hh) * RB + pos0 + row) * 64 + d0;
        *(u32x4*)dst = o;
      } else if (n0 < 1536) {
        const int hh = (n0 - 1024) >> 7;
        bf16_t* dst = (bf16_t*)(ws + OFF_VDAT) + ((size_t)((b * 4 + hh) * 128 + row)) * RB + pos0 + ch * 8;
        *(u32x4*)dst = o;
      } else if (n0 < 1920) {
        *(u32x4*)((bf16_t*)(ws + OFF_CQ) + (size_t)(m0 + row) * 384 + (n0 - 1536) + ch * 8) = o;
      } else if (n0 < 2176) {
        *(u32x4*)((bf16_t*)(ws + OFF_CKV) + (size_t)(m0 + row) * 256 + (n0 - 1920) + ch * 8) = o;
      } else if (ch < 4) {
        *(u32x4*)((bf16_t*)(ws + OFF_KR) + (size_t)(m0 + row) * 32 + ch * 8) = o;
      }
    }
  }
};
struct EpiUq {
  char* ws;
  DI bool transposed(int) const { return false; }
  DI void store(const float* Cs, int m0, int n0) const {
    const int tid = get_tid();
    const int b = row_b(m0), pos0 = m0 - b * RB;
#pragma unroll 2
    for (int i = 0; i < 8; i++) {
      const int c = tid + 256 * i, row = c >> 4, ch = c & 15;
      float v[8]; ld8f(Cs + row * CS + ch * 8, v);
      const int col0 = n0 + ch * 8, hh = col0 / 96, e0 = col0 - hh * 96;
      *(u32x4*)((bf16_t*)(ws + OFF_QMLA) + ((size_t)(b * 8 + hh) * RB + pos0 + row) * 96 + e0) = pk8(v);
    }
  }
};
struct EpiUkv {
  char* ws;
  DI bool transposed(int n0) const { return n0 >= 512; }
  DI void store(const float* Cs, int m0, int n0) const {
    const int tid = get_tid();
    const int b = row_b(m0), pos0 = m0 - b * RB;
#pragma unroll 2
    for (int i = 0; i < 8; i++) {
      const int c = tid + 256 * i, row = c >> 4, ch = c & 15;
      float v[8]; ld8f(Cs + row * CS + ch * 8, v);
      if (n0 < 512) {
        const int col0 = n0 + ch * 8, hh = col0 >> 6, e0 = col0 & 63;
        *(u32x4*)((bf16_t*)(ws + OFF_KMLA) + ((size_t)(b * 8 + hh) * RB + pos0 + row) * 96 + e0) = pk8(v);
      } else {
        const int nn = n0 - 512 + row, hh = nn >> 6, dv = nn & 63;
        *(u32x4*)((bf16_t*)(ws + OFF_VMLAT) + ((size_t)((b * 8 + hh) * 64 + dv)) * RB + pos0 + ch * 8) = pk8(v);
      }
    }
  }
};
struct EpiResid {
  const float* x; const float* ctx; float* hlat; float* hctx; const float* modv_l; int gidx; bool from_input;
  DI bool transposed(int) const { return false; }
  DI void store(const float* Cs, int m0, int n0) const {
    const int tid = get_tid();
    const int b = row_b(m0), pos0 = m0 - b * RB;
    const bool isctx = pos0 < NCTX;
    const float* gate = modv_l + (size_t)(isctx ? 2 : b) * 6144 + gidx * 1024 + n0;
    const float* src = isctx ? (from_input ? ctx : hctx) : (from_input ? x : hlat);
    float* dst = isctx ? hctx : hlat;
    const size_t rbase = isctx ? (size_t)(b * NCTX + pos0) : (size_t)(b * SEQ + pos0 - NCTX);
#pragma unroll 4
    for (int i = 0; i < 16; i++) {
      const int c = tid + 256 * i, row = c >> 5, ch = c & 31;
      const float4 v = *(const float4*)(Cs + row * CS + ch * 4);
      const float4 g = *(const float4*)(gate + ch * 4);
      const size_t o = (rbase + row) * 1024 + n0 + ch * 4;
      const float4 hv = *(const float4*)(src + o);
      float4 r4; r4.x = hv.x + g.x * v.x; r4.y = hv.y + g.y * v.y; r4.z = hv.z + g.z * v.z; r4.w = hv.w + g.w * v.w;
      *(float4*)(dst + o) = r4;
    }
  }
};
struct EpiCtxPartial {
  float* ctxp; int ks;
  DI bool transposed(int) const { return false; }
  DI void store(const float* Cs, int m0, int n0) const {
    const int tid = get_tid();
    const int b = row_b(m0), pos0 = m0 - b * RB;
    float* dst = ctxp + ((size_t)ks * (NB * NCTX) + (size_t)(b * NCTX + pos0)) * 1024 + n0;
#pragma unroll 4
    for (int i = 0; i < 16; i++) {
      const int c = tid + 256 * i, row = c >> 5, ch = c & 31;
      *(float4*)(dst + (size_t)row * 1024 + ch * 4) = *(const float4*)(Cs + row * CS + ch * 4);
    }
  }
};
struct EpiMlpIn {
  bf16_t* hid;
  DI bool transposed(int) const { return false; }
  DI void store(const float* Cs, int m0, int n0) const {
    const int tid = get_tid();
#pragma unroll 2
    for (int i = 0; i < 8; i++) {
      const int c = tid + 256 * i, row = c >> 4, ch = c & 15;
      float v[8]; ld8f(Cs + row * CS + ch * 8, v);
#pragma unroll
      for (int q = 0; q < 8; q++) { const float t = fmaxf(v[q], 0.f); v[q] = t * t; }
      *(u32x4*)(hid + (size_t)(m0 + row) * HID + n0 + ch * 8) = pk8(v);
    }
  }
};
struct EpiRecIn {
  char* ws; const float* dt_bias;
  DI bool transposed(int) const { return false; }
  DI void store(const float* Cs, int m0, int n0) const {
    const int tid = get_tid();
    if (n0 < 4096) {
      const int seg = n0 >> 9;
#pragma unroll 2
      for (int i = 0; i < 8; i++) {
        const int c = tid + 256 * i, row = c >> 4, ch = c & 15;
        float v[8]; ld8f(Cs + row * CS + ch * 8, v);
        if (seg == 0 || seg == 4 || seg == 5) {
#pragma unroll
          for (int q = 0; q < 8; q++) v[q] = silu_f(v[q]);
        } else if (seg == 1 || seg == 2) {
          const float* lb = (const float*)(ws + OFF_LB) + (n0 - 512) + ch * 8;
#pragma unroll
          for (int q = 0; q < 8; q++) v[q] = __logf(lb[q] + (1.f - lb[q]) * sigmoid_f(v[q]));
        }
        if (n0 < 3072) *(u32x4*)((bf16_t*)(ws + OFF_P1) + (size_t)(m0 + row) * 3072 + n0 + ch * 8) = pk8(v);
        else *(u32x4*)((bf16_t*)(ws + OFF_XBC) + (size_t)(m0 + row) * 1024 + (n0 - 3072) + ch * 8) = pk8(v);
      }
    } else {
      const int row = tid >> 1, c0 = (tid & 1) * 8;
      float* DT = (float*)(ws + OFF_DT) + (size_t)(m0 + row) * 16 + c0;
#pragma unroll
      for (int q = 0; q < 8; q++) {
        const float t = Cs[row * CS + c0 + q] + dt_bias[c0 + q];
        DT[q] = t > 20.f ? t : log1pf(__expf(t));
      }
    }
  }
};

DI void gemm_ctx_splitk(const bf16_t* A, int lda, const bf16_t* Bt, int ldb, int K, float* ctxp, char* smem) {
  bf16_t* sa = (bf16_t*)smem;
  bf16_t* sb = sa + 2 * 128 * GS;
  const int kslice = K >> 2;
  for (int u = gridDim.x - 1 - blockIdx.x; u < 128; u += gridDim.x) {
    const int ks = u & 3, t = u >> 2, nt_ = t & 7, mt = t >> 3;
    const int m0 = (mt >> 1) * RB + (mt & 1) * 128, n0 = nt_ * 128;
    gemm_tile(A + ks * kslice, lda, Bt + ks * kslice, ldb, kslice, m0, n0, EpiCtxPartial{ctxp, ks}, sa, sb);
  }
}

template <class Epi>
DI void gemm_tile256(const bf16_t* __restrict__ A, int lda, const bf16_t* __restrict__ Bt, int ldb, int K, int m0, int n0,
                     const Epi& epi, bf16_t* sa, bf16_t* sb) {
  const int tid = get_tid(), lane = tid & 63, w = tid >> 6, r = lane & 31, h = lane >> 5;
  const int wm = w >> 1, wn = w & 1;
  f32x16 acc[2][4];
#pragma unroll
  for (int i = 0; i < 2; i++)
#pragma unroll
    for (int j = 0; j < 4; j++)
#pragma unroll
      for (int e = 0; e < 16; e++) acc[i][j][e] = 0.f;
  const int lrow = tid >> 3, lc = (tid & 7) * 8;
  const bf16_t* ga = A + (size_t)(m0 + lrow) * lda + lc;
  const bf16_t* gb = Bt + (size_t)(n0 + lrow) * ldb + lc;
  u32x4 ra[4], rb[8];
  const int nk = K >> 6;
#pragma unroll
  for (int i = 0; i < 4; i++) ra[i] = *(const u32x4*)(ga + (size_t)(32 * i) * lda);
#pragma unroll
  for (int i = 0; i < 8; i++) rb[i] = *(const u32x4*)(gb + (size_t)(32 * i) * ldb);
  for (int kt = 0; kt < nk; kt++) {
    __syncthreads();
#pragma unroll
    for (int i = 0; i < 4; i++) *(u32x4*)(sa + (lrow + 32 * i) * GS + lc) = ra[i];
#pragma unroll
    for (int i = 0; i < 8; i++) *(u32x4*)(sb + (lrow + 32 * i) * GS + lc) = rb[i];
    __syncthreads();
    {
      const int k0 = (kt + 1 < nk ? kt + 1 : kt) << 6;
#pragma unroll
      for (int i = 0; i < 4; i++) ra[i] = *(const u32x4*)(ga + (size_t)(32 * i) * lda + k0);
#pragma unroll
      for (int i = 0; i < 8; i++) rb[i] = *(const u32x4*)(gb + (size_t)(32 * i) * ldb + k0);
    }
    __builtin_amdgcn_sched_barrier(0);
    __builtin_amdgcn_s_setprio(1);
#pragma unroll
    for (int s = 0; s < 4; s++) {
      bf16x8 af[2], bq[4];
#pragma unroll
      for (int i = 0; i < 2; i++) af[i] = *(const bf16x8*)(sa + (wm * 64 + i * 32 + r) * GS + s * 16 + h * 8);
#pragma unroll
      for (int j = 0; j < 4; j++) bq[j] = *(const bf16x8*)(sb + (wn * 128 + j * 32 + r) * GS + s * 16 + h * 8);
#pragma unroll
      for (int i = 0; i < 2; i++)
#pragma unroll
        for (int j = 0; j < 4; j++) acc[i][j] = MFMA32(bq[j], af[i], acc[i][j]);
    }
    __builtin_amdgcn_s_setprio(0);
  }
  float* Cs = (float*)sa;
#pragma unroll
  for (int hn = 0; hn < 2; hn++) {
    __syncthreads();
    const bool tr = epi.transposed(n0 + hn * 128);
    if (wn == hn) {
#pragma unroll
      for (int i = 0; i < 2; i++)
#pragma unroll
        for (int j = 0; j < 4; j++)
#pragma unroll
          for (int g = 0; g < 4; g++) {
            const int m = wm * 64 + i * 32 + r, n = j * 32 + 8 * g + 4 * h;
            if (!tr) {
              float4 v; v.x = acc[i][j][4 * g]; v.y = acc[i][j][4 * g + 1]; v.z = acc[i][j][4 * g + 2]; v.w = acc[i][j][4 * g + 3];
              *(float4*)(Cs + m * CS + n) = v;
            } else {
              Cs[(n + 0) * CS + m] = acc[i][j][4 * g]; Cs[(n + 1) * CS + m] = acc[i][j][4 * g + 1];
              Cs[(n + 2) * CS + m] = acc[i][j][4 * g + 2]; Cs[(n + 3) * CS + m] = acc[i][j][4 * g + 3];
            }
          }
    }
    __syncthreads();
    epi.store(Cs, m0, n0 + hn * 128);
  }
  __syncthreads();
}

using f32x4v = __attribute__((ext_vector_type(4))) float;
#define MFMA16(a, b, c) __builtin_amdgcn_mfma_f32_16x16x32_bf16((a), (b), (c), 0, 0, 0)
DI int swz(int row, int chunk) { return row * 64 + ((chunk ^ ((row >> 1) & 7)) << 3); }
template <class Epi>
DI void gemm_tile256s(const bf16_t* __restrict__ A, int lda, const bf16_t* __restrict__ Bt, int ldb, int K, int m0, int n0,
                      const Epi& epi, bf16_t* sa, bf16_t* sb) {
  const int tid = get_tid(), lane = tid & 63, w = tid >> 6, lr = lane & 15, q = lane >> 4;
  const int wm = w >> 1, wn = w & 1;
  f32x4v acc[4][8];
#pragma unroll
  for (int i = 0; i < 4; i++)
#pragma unroll
    for (int j = 0; j < 8; j++)
#pragma unroll
      for (int e = 0; e < 4; e++) acc[i][j][e] = 0.f;
  const int lrow = tid >> 3, lch = tid & 7;
  const bf16_t* ga = A + (size_t)(m0 + lrow) * lda + lch * 8;
  const bf16_t* gb = Bt + (size_t)(n0 + lrow) * ldb + lch * 8;
  u32x4 ra[4], rb[8];
  const int nk = K >> 6;
#pragma unroll
  for (int i = 0; i < 4; i++) ra[i] = *(const u32x4*)(ga + (size_t)(32 * i) * lda);
#pragma unroll
  for (int i = 0; i < 8; i++) rb[i] = *(const u32x4*)(gb + (size_t)(32 * i) * ldb);
  for (int kt = 0; kt < nk; kt++) {
    __syncthreads();
#pragma unroll
    for (int i = 0; i < 4; i++) *(u32x4*)(sa + swz(lrow + 32 * i, lch)) = ra[i];
#pragma unroll
    for (int i = 0; i < 8; i++) *(u32x4*)(sb + swz(lrow + 32 * i, lch)) = rb[i];
    __syncthreads();
    {
      const int k0 = (kt + 1 < nk ? kt + 1 : kt) << 6;
#pragma unroll
      for (int i = 0; i < 4; i++) ra[i] = *(const u32x4*)(ga + (size_t)(32 * i) * lda + k0);
#pragma unroll
      for (int i = 0; i < 8; i++) rb[i] = *(const u32x4*)(gb + (size_t)(32 * i) * ldb + k0);
    }
    __builtin_amdgcn_sched_barrier(0);
    __builtin_amdgcn_s_setprio(1);
#pragma unroll
    for (int ks = 0; ks < 2; ks++) {
      bf16x8 af[4], bq[8];
#pragma unroll
      for (int i = 0; i < 4; i++) af[i] = *(const bf16x8*)(sa + swz(wm * 64 + i * 16 + lr, ks * 4 + q));
#pragma unroll
      for (int j = 0; j < 8; j++) bq[j] = *(const bf16x8*)(sb + swz(wn * 128 + j * 16 + lr, ks * 4 + q));
#pragma unroll
      for (int i = 0; i < 4; i++)
#pragma unroll
        for (int j = 0; j < 8; j++) acc[i][j] = MFMA16(bq[j], af[i], acc[i][j]);
    }
    __builtin_amdgcn_s_setprio(0);
  }
  float* Cs = (float*)sa;
#pragma unroll
  for (int hn = 0; hn < 2; hn++) {
    __syncthreads();
    const bool tr = epi.transposed(n0 + hn * 128);
    if (wn == hn) {
#pragma unroll
      for (int i = 0; i < 4; i++)
#pragma unroll
        for (int j = 0; j < 8; j++) {
          const int m = wm * 64 + i * 16 + lr, n = j * 16 + 4 * q;
          if (!tr) {
            float4 v; v.x = acc[i][j][0]; v.y = acc[i][j][1]; v.z = acc[i][j][2]; v.w = acc[i][j][3];
            *(float4*)(Cs + m * CS + n) = v;
          } else {
            Cs[(n + 0) * CS + m] = acc[i][j][0]; Cs[(n + 1) * CS + m] = acc[i][j][1];
            Cs[(n + 2) * CS + m] = acc[i][j][2]; Cs[(n + 3) * CS + m] = acc[i][j][3];
          }
        }
    }
    __syncthreads();
    epi.store(Cs, m0, n0 + hn * 128);
  }
  __syncthreads();
}

template <class Epi>
DI void gemm_phase256(const bf16_t* A, int lda, const bf16_t* Bt, int ldb, int N, int K, const Epi& epi, char* smem) {
  bf16_t* sa = (bf16_t*)smem;
  bf16_t* sb = sa + 128 * GS;
  const int tn = N / 256, tm = (NB * SEQ) / 128;
  const int xcd = blockIdx.x & 7, rank = blockIdx.x >> 3, per = gridDim.x >> 3;
  const int mlo = (xcd * tm) >> 3, mhi = ((xcd + 1) * tm) >> 3, tmx = mhi - mlo;
  for (int L = rank; L < tmx * tn; L += per) {
    const int panel = L / (8 * tn), rem = L - panel * 8 * tn;
    const int nt_ = rem >> 3, mt = mlo + panel * 8 + (rem & 7);
    const int m0 = (mt >> 6) * RB + NCTX + (mt & 63) * 128;
    gemm_tile256s(A, lda, Bt, ldb, K, m0, nt_ * 256, epi, sa, sb);
  }
}

DI void rope_cs(int s_lat, int i, int nfreq, float& cs, float& sn) {
  const int rowp = s_lat >> 6, colp = s_lat & 63;
  const int fi = i < nfreq ? i : i - nfreq;
  const float inv = exp2f(-(float)fi / (float)nfreq * 13.287712379549449f);
  const float ang = (float)(i < nfreq ? rowp : colp) * inv;
  sn = __sinf(ang); cs = __cosf(ang);
}

DI void att_post_phase(const Params& p) {
  const int lane = get_tid() & 63, w = get_tid() >> 6;
  bf16_t* KDA = (bf16_t*)(p.ws + OFF_KDA);
  bf16_t* CQ = (bf16_t*)(p.ws + OFF_CQ);
  bf16_t* CKV = (bf16_t*)(p.ws + OFF_CKV);
  const bf16_t* KR = (const bf16_t*)(p.ws + OFF_KR);
  bf16_t* KMLA = (bf16_t*)(p.ws + OFF_KMLA);
  for (int row = blockIdx.x * 4 + w; row < R; row += gridDim.x * 4) {
    const int b = row_b(row), pos = row - b * RB;
    const bool lat = pos >= NCTX;
    const int s_lat = pos - NCTX;
    if (lat) {
#pragma unroll
      for (int q = 0; q < 4; q++) {
        const int pi = q * 64 + lane, vec = pi >> 5, i = pi & 31;
        bf16_t* kp = KDA + ((size_t)(b * 8 + vec) * RB + pos) * 64;
        float cs, sn; rope_cs(s_lat, i, 16, cs, sn);
        const float x1 = bf2f(kp[i]), x2 = bf2f(kp[i + 32]);
        kp[i] = f2bf(x1 * cs - x2 * sn);
        kp[i + 32] = f2bf(x1 * sn + x2 * cs);
      }
    }
    {
      bf16_t* cq = CQ + (size_t)row * 384;
      float v[6], ss = 0.f;
#pragma unroll
      for (int i = 0; i < 6; i++) { v[i] = bf2f(cq[i * 64 + lane]); ss += v[i] * v[i]; }
      ss = wave_sum(ss);
      const float rstd = rsqrtf(ss * (1.f / 384.f) + EPS);
#pragma unroll
      for (int i = 0; i < 6; i++) cq[i * 64 + lane] = f2bf(v[i] * rstd * p.mla_q_norm[i * 64 + lane]);
    }
    {
      bf16_t* ck = CKV + (size_t)row * 256;
      float v[4], ss = 0.f;
#pragma unroll
      for (int i = 0; i < 4; i++) { v[i] = bf2f(ck[i * 64 + lane]); ss += v[i] * v[i]; }
      ss = wave_sum(ss);
      const float rstd = rsqrtf(ss * (1.f / 256.f) + EPS);
#pragma unroll
      for (int i = 0; i < 4; i++) ck[i * 64 + lane] = f2bf(v[i] * rstd * p.mla_kv_norm[i * 64 + lane]);
    }
    {
      const bf16_t* kr = KR + (size_t)row * 32;
      const int i = lane & 15;
      const float x1 = bf2f(kr[i]), x2 = bf2f(kr[i + 16]);
      float o1 = x1, o2 = x2;
      if (lat) { float cs, sn; rope_cs(s_lat, i, 8, cs, sn); o1 = x1 * cs - x2 * sn; o2 = x1 * sn + x2 * cs; }
      const bf16_t b1 = f2bf(o1), b2 = f2bf(o2);
#pragma unroll
      for (int q = 0; q < 2; q++) {
        const int hh = (lane >> 4) + 4 * q;
        bf16_t* kd = KMLA + ((size_t)(b * 8 + hh) * RB + pos) * 96 + 64;
        kd[i] = b1; kd[i + 16] = b2;
      }
    }
  }
}

template <int DK, int DV>
DI void attn_item(const bf16_t* __restrict__ Q, const bf16_t* __restrict__ Kp, const bf16_t* __restrict__ VT, int ldv, int nkeys,
                  float sc_log2e, int s_lat0  , bf16_t* __restrict__ out, int ostride,
                  char* smem) {
  constexpr int KS = DK + 8;
  constexpr int VS = 68;
  constexpr int NKS = DK / 16;
  constexpr int ND = DV / 32;
  constexpr int KCH = (64 * DK / 8) / 256;
  constexpr int VCH = (DV * 8) / 256;
  constexpr int KBUF = 64 * KS, VBUF = DV * VS;
  bf16_t* sk = (bf16_t*)smem;
  bf16_t* sv = sk + 2 * KBUF;
  const int tid = get_tid(), lane = tid & 63, w = tid >> 6, r = lane & 31, h = lane >> 5;

  bf16x8 qf[NKS];
  const bf16_t* qrow = Q + (size_t)(w * 32 + r) * DK;
#pragma unroll
  for (int s = 0; s < NKS; s++) qf[s] = *(const bf16x8*)(qrow + s * 16 + h * 8);
  if (s_lat0 >= 0) {
    const int s_lat = s_lat0 + w * 32 + r;
    if (DK == 64) {
#pragma unroll
      for (int s = 0; s < 2; s++)
#pragma unroll
        for (int j = 0; j < 8; j++) {
          float cs, sn; rope_cs(s_lat, 16 * s + 8 * h + j, 16, cs, sn);
          const float x1 = bf2f((bf16_t)qf[s][j]), x2 = bf2f((bf16_t)qf[s + 2][j]);
          qf[s][j] = (short)f2bf((x1 * cs - x2 * sn) * sc_log2e);
          qf[s + 2][j] = (short)f2bf((x1 * sn + x2 * cs) * sc_log2e);
        }
    } else {
#pragma unroll
      for (int s = 0; s < NKS - 2; s++)
#pragma unroll
        for (int j = 0; j < 8; j++) qf[s][j] = (short)f2bf(bf2f((bf16_t)qf[s][j]) * sc_log2e);
#pragma unroll
      for (int j = 0; j < 8; j++) {
        float cs, sn; rope_cs(s_lat, 8 * h + j, 8, cs, sn);
        const float x1 = bf2f((bf16_t)qf[NKS - 2][j]), x2 = bf2f((bf16_t)qf[NKS - 1][j]);
        qf[NKS - 2][j] = (short)f2bf((x1 * cs - x2 * sn) * sc_log2e);
        qf[NKS - 1][j] = (short)f2bf((x1 * sn + x2 * cs) * sc_log2e);
      }
    }
  } else {
#pragma unroll
    for (int s = 0; s < NKS; s++)
#pragma unroll
      for (int j = 0; j < 8; j++) qf[s][j] = (short)f2bf(bf2f((bf16_t)qf[s][j]) * sc_log2e);
  }

  f32x16 O[ND];
#pragma unroll
  for (int d = 0; d < ND; d++)
#pragma unroll
    for (int e = 0; e < 16; e++) O[d][e] = 0.f;
  float m_run = 0.f;
  hf2 lsum = {0.f, 0.f};

  u32x4 rkA[KCH], rvA[VCH], rkB[KCH], rvB[VCH];
  auto gload_k = [&](int kt, u32x4* rk) {
#pragma unroll
    for (int i = 0; i < KCH; i++) {
      const int c = tid + 256 * i;
      rk[i] = *(const u32x4*)(Kp + (size_t)kt * 64 * DK + (size_t)c * 8);
    }
  };
  auto gload_v = [&](int kt, u32x4* rv) {
#pragma unroll
    for (int i = 0; i < VCH; i++) {
      const int c = tid + 256 * i, d = c >> 3, cc = c & 7;
      rv[i] = *(const u32x4*)(VT + (size_t)d * ldv + kt * 64 + cc * 8);
    }
  };
  auto stage_k = [&](bf16_t* pk, const u32x4* rk) {
#pragma unroll
    for (int i = 0; i < KCH; i++) {
      const int c = tid + 256 * i, row = c / (DK / 8), cc = c % (DK / 8);
      *(u32x4*)(pk + row * KS + cc * 8) = rk[i];
    }
  };
  auto stage_v = [&](bf16_t* pv, const u32x4* rv) {
#pragma unroll
    for (int i = 0; i < VCH; i++) {
      const int c = tid + 256 * i, d = c >> 3, cc = c & 7;
      u32x2 lo, hi; lo.x = rv[i].x; lo.y = rv[i].y; hi.x = rv[i].z; hi.y = rv[i].w;
      *(u32x2*)(pv + d * VS + cc * 8) = lo;
      *(u32x2*)(pv + d * VS + cc * 8 + 4) = hi;
    }
  };
  f32x16 negm = {0.f, 0.f, 0.f, 0.f, 0.f, 0.f, 0.f, 0.f, 0.f, 0.f, 0.f, 0.f, 0.f, 0.f, 0.f, 0.f};
  bool first = true;
  auto qk = [&](const bf16_t* pk, f32x16* S) {
    bf16x8 kf[2][NKS];
#pragma unroll
    for (int sub = 0; sub < 2; sub++)
#pragma unroll
      for (int s = 0; s < NKS; s++) kf[sub][s] = *(const bf16x8*)(pk + (sub * 32 + r) * KS + s * 16 + h * 8);
    __builtin_amdgcn_sched_barrier(0);
#pragma unroll
    for (int s = 0; s < NKS; s++)
#pragma unroll
      for (int sub = 0; sub < 2; sub++) S[sub] = MFMA32(kf[sub][s], qf[s], s == 0 ? negm : S[sub]);
  };
  const int nt = nkeys >> 6;
  auto vfrag = [&](const bf16_t* pv, int d, int q) -> bf16x8 {
    const bf16_t* vp = pv + (d * 32 + r) * VS + q * 16 + 4 * h;
    const s16x4 lo = *(const s16x4*)vp;
    const s16x4 hi = *(const s16x4*)(vp + 8);
    return __builtin_shufflevector(lo, hi, 0, 1, 2, 3, 4, 5, 6, 7);
  };
  __syncthreads();
  gload_k(0, rkA); gload_v(0, rvA);
  gload_k(1, rkB); gload_v(1, rvB);
  auto tile_body = [&](const bf16_t* pk, const bf16_t* pv) {
    f32x16 S[2];
      qk(pk, S);
      bf16x8 vf[2][4];
#pragma unroll
      for (int q = 0; q < 4; q++) vf[0][q] = vfrag(pv, 0, q);
      __builtin_amdgcn_sched_barrier(0);
      float mx = max3f(S[0][0], S[0][1], S[0][2]);
#pragma unroll
      for (int e = 3; e < 15; e += 2) mx = max3f(mx, S[0][e], S[0][e + 1]);
      mx = max3f(mx, S[0][15], S[1][0]);
#pragma unroll
      for (int e = 1; e < 15; e += 2) mx = max3f(mx, S[1][e], S[1][e + 1]);
      mx = fmaxf(mx, S[1][15]);
      mx = xmax(mx);
      const bool need = first || (mx > 6.0f);
      if (__any(need)) {
        asm volatile("; rare rescale path" ::: "memory");
        const float delta = need ? mx : 0.f;
        const float alpha = first ? 1.f : __builtin_amdgcn_exp2f(-delta);
        m_run += delta;
#pragma unroll
        for (int e = 0; e < 16; e++) negm[e] = -m_run;
#pragma unroll
        for (int sub = 0; sub < 2; sub++)
#pragma unroll
          for (int e = 0; e < 16; e++) S[sub][e] -= delta;
        lsum.x *= alpha;
#pragma unroll
        for (int d = 0; d < ND; d++)
#pragma unroll
          for (int e = 0; e < 16; e++) O[d][e] *= alpha;
      }
      first = false;
#pragma unroll
      for (int sub = 0; sub < 2; sub++)
#pragma unroll
        for (int e = 0; e < 16; e += 2) {
          const float p0 = __builtin_amdgcn_exp2f(S[sub][e]), p1 = __builtin_amdgcn_exp2f(S[sub][e + 1]);
          S[sub][e] = p0; S[sub][e + 1] = p1;
          lsum.x += p0; lsum.x += p1;
        }
      bf16x8 pb[4];
#pragma unroll
      for (int q = 0; q < 4; q++) {
        const int sub = q >> 1, s2 = q & 1;
        u32x4 t;
        t.x = pack2(S[sub][8 * s2 + 0], S[sub][8 * s2 + 1]); t.y = pack2(S[sub][8 * s2 + 2], S[sub][8 * s2 + 3]);
        t.z = pack2(S[sub][8 * s2 + 4], S[sub][8 * s2 + 5]); t.w = pack2(S[sub][8 * s2 + 6], S[sub][8 * s2 + 7]);
        pb[q] = __builtin_bit_cast(bf16x8, t);
      }
      __builtin_amdgcn_s_setprio(1);
#pragma unroll
      for (int d = 0; d < ND; d++) {
        if (d + 1 < ND) {
#pragma unroll
          for (int q = 0; q < 4; q++) vf[(d + 1) & 1][q] = vfrag(pv, d + 1, q);
        }
        __builtin_amdgcn_sched_barrier(0);
#pragma unroll
        for (int q = 0; q < 4; q++) O[d] = MFMA32(vf[d & 1][q], pb[q], O[d]);
      }
      __builtin_amdgcn_s_setprio(0);
  };
  for (int kt = 0; kt < nt; kt += 2) {
    {
      bf16_t* pk = sk; bf16_t* pv = sv;
      stage_k(pk, rkA); stage_v(pv, rvA);
      __syncthreads();
      const int kn = kt + 2 < nt ? kt + 2 : kt;
      gload_k(kn, rkA); gload_v(kn, rvA);
      __builtin_amdgcn_sched_barrier(0);
      tile_body(pk, pv);
    }
    {
      bf16_t* pk = sk + KBUF; bf16_t* pv = sv + VBUF;
      stage_k(pk, rkB); stage_v(pv, rvB);
      __syncthreads();
      const int kn = kt + 3 < nt ? kt + 3 : kt + 1;
      gload_k(kn, rkB); gload_v(kn, rvB);
      __builtin_amdgcn_sched_barrier(0);
      tile_body(pk, pv);
    }
  }
  __syncthreads();
  const float l_run = lsum.x + lsum.y;
  const float lt = xsum(l_run);
  const float inv = 1.f / lt;
  bf16_t* orow = out + (size_t)(w * 32 + r) * ostride;
#pragma unroll
  for (int d = 0; d < ND; d++)
#pragma unroll
    for (int g = 0; g < 4; g++) {
      u32x2 pk2;
      pk2.x = pack2(O[d][4 * g] * inv, O[d][4 * g + 1] * inv);
      pk2.y = pack2(O[d][4 * g + 2] * inv, O[d][4 * g + 3] * inv);
      *(u32x2*)(orow + d * 32 + 8 * g + 4 * h) = pk2;
    }
}

DI void attention_phase(const Params& p, char* smem) {
  const bf16_t* QDA = (const bf16_t*)(p.ws + OFF_QDA);
  const bf16_t* KDA = (const bf16_t*)(p.ws + OFF_KDA);
  const bf16_t* VDAT = (const bf16_t*)(p.ws + OFF_VDAT);
  const bf16_t* QMLA = (const bf16_t*)(p.ws + OFF_QMLA);
  const bf16_t* KMLA = (const bf16_t*)(p.ws + OFF_KMLA);
  const bf16_t* VMLAT = (const bf16_t*)(p.ws + OFF_VMLAT);
  bf16_t* Y = (bf16_t*)(p.ws + OFF_U);
  bf16_t* OA1 = (bf16_t*)(p.ws + OFF_OA1);
  const float da_sc = 0.125f * LOG2E;
  const float mla_sc = 0.10206207261596577f * LOG2E;
  const int xcd = blockIdx.x & 7, rank = blockIdx.x >> 3, per = gridDim.x >> 3;
  const int nlong = (per == 64) ? 4 : 0;
  for (int j = 0; j < nlong + 1 + 2048 / (int)gridDim.x + 1; j++) {
    int it;
    if (j < nlong) it = ((j * 8 + xcd) << 6) + rank;
    else { it = (nlong ? 2048 : 0) + (j - nlong) * gridDim.x + blockIdx.x; }
    if (it >= 2112) break;
    bool da, isctx; int qb, combo;
    if (it < 1024) { da = true; isctx = false; qb = it & 63; combo = it >> 6; }
    else if (it < 2048) { da = false; isctx = false; qb = it & 63; combo = (it - 1024) >> 6; }
    else if (it < 2080) { da = true; isctx = true; qb = it & 1; combo = (it - 2048) >> 1; }
    else { da = false; isctx = true; qb = it & 1; combo = (it - 2080) >> 1; }
    const int pos0 = isctx ? qb * 128 : NCTX + qb * 128;
    const int nkeys = isctx ? NCTX : RB;
    const int s_lat0 = isctx ? -1 : qb * 128;
    if (da) {
      const int hh = combo & 3, m = (combo >> 2) & 1, b = combo >> 3;
      const size_t base = (size_t)((b * 2 + m) * 4 + hh) * RB;
      const size_t grow = (size_t)b * RB + pos0;
      bf16_t* o = m == 0 ? (Y + grow * 1024 + hh * 128) : (OA1 + grow * 512 + hh * 128);
      attn_item<64, 128>(QDA + (base + pos0) * 64, KDA + base * 64, VDAT + (size_t)((b * 4 + hh) * 128) * RB, RB, nkeys, da_sc,
                         s_lat0, o, m == 0 ? 1024 : 512, smem);
    } else {
      const int hh = combo & 7, b = combo >> 3;
      const size_t base = (size_t)(b * 8 + hh) * RB;
      const size_t grow = (size_t)b * RB + pos0;
      attn_item<96, 64>(QMLA + (base + pos0) * 96, KMLA + base * 96, VMLAT + (size_t)((b * 8 + hh) * 64) * RB, RB, nkeys, mla_sc,
                        s_lat0, Y + grow * 1024 + 512 + hh * 64, 1024, smem);
    }
  }
}

DI void da_merge_phase(const Params& p) {
  const int lane = get_tid() & 63, w = get_tid() >> 6;
  bf16_t* Y = (bf16_t*)(p.ws + OFF_U);
  const bf16_t* OA1 = (const bf16_t*)(p.ws + OFF_OA1);
  const float* lp = p.att_lambda;
  const float s1 = wave_sum(lp[lane] * lp[64 + lane]);
  const float s2 = wave_sum(lp[128 + lane] * lp[192 + lane]);
  const float lam_init = 0.2f;
  const float lam = __expf(s1) - __expf(s2) + lam_init;
  float g[8];
#pragma unroll
  for (int j = 0; j < 8; j++) g[j] = p.att_subnorm[(lane & 15) * 8 + j] * (1.f - lam_init);
  for (int row = blockIdx.x * 4 + w; row < R; row += gridDim.x * 4) {
    u32x4 a = *(const u32x4*)(Y + (size_t)row * 1024 + lane * 8);
    u32x4 b4 = *(const u32x4*)(OA1 + (size_t)row * 512 + lane * 8);
    const unsigned au[4] = {a.x, a.y, a.z, a.w}, bu[4] = {b4.x, b4.y, b4.z, b4.w};
    float d[8], ss = 0.f;
#pragma unroll
    for (int j = 0; j < 4; j++) {
      d[2 * j] = bf2f((bf16_t)(au[j] & 0xffff)) - lam * bf2f((bf16_t)(bu[j] & 0xffff));
      d[2 * j + 1] = bf2f((bf16_t)(au[j] >> 16)) - lam * bf2f((bf16_t)(bu[j] >> 16));
      ss += d[2 * j] * d[2 * j] + d[2 * j + 1] * d[2 * j + 1];
    }
#pragma unroll
    for (int o = 8; o >= 1; o >>= 1) ss += __shfl_xor(ss, o, 64);
    const float rstd = rsqrtf(ss * (1.f / 128.f) + EPS);
    u32x4 o4;
    o4.x = pack2(d[0] * rstd * g[0], d[1] * rstd * g[1]);
    o4.y = pack2(d[2] * rstd * g[2], d[3] * rstd * g[3]);
    o4.z = pack2(d[4] * rstd * g[4], d[5] * rstd * g[5]);
    o4.w = pack2(d[6] * rstd * g[6], d[7] * rstd * g[7]);
    *(u32x4*)(Y + (size_t)row * 1024 + lane * 8) = o4;
  }
}

DI void conv_phase(const Params& p) {
  const bf16_t* XBC = (const bf16_t*)(p.ws + OFF_XBC);
  bf16_t* XC = (bf16_t*)(p.ws + OFF_XC);
  const int total = R * 128;
  for (int idx = blockIdx.x * 256 + get_tid(); idx < total; idx += gridDim.x * 256) {
    const int row = idx >> 7, c0 = (idx & 127) * 8;
    const int b = row_b(row), pos = row - b * RB;
    const int lo = pos < NCTX ? 0 : NCTX, hi = pos < NCTX ? NCTX : RB;
    float acc[8];
#pragma unroll
    for (int j = 0; j < 8; j++) acc[j] = p.ssd_conv_b[c0 + j];
#pragma unroll
    for (int t = 0; t < 5; t++) {
      const int pp = pos + t - 2;
      if (pp < lo || pp >= hi) continue;
      const u32x4 xv = *(const u32x4*)(XBC + (size_t)(b * RB + pp) * 1024 + c0);
      const unsigned xu[4] = {xv.x, xv.y, xv.z, xv.w};
      const float* wr = p.ssd_conv_w + t * 1024 + c0;
#pragma unroll
      for (int j = 0; j < 4; j++) {
        acc[2 * j] += wr[2 * j] * bf2f((bf16_t)(xu[j] & 0xffff));
        acc[2 * j + 1] += wr[2 * j + 1] * bf2f((bf16_t)(xu[j] >> 16));
      }
    }
    u32x4 o;
    o.x = pack2(silu_f(acc[0]), silu_f(acc[1])); o.y = pack2(silu_f(acc[2]), silu_f(acc[3]));
    o.z = pack2(silu_f(acc[4]), silu_f(acc[5])); o.w = pack2(silu_f(acc[6]), silu_f(acc[7]));
    *(u32x4*)(XC + (size_t)row * 1024 + c0) = o;
  }
}

DI int scan_pos(int dir, int step) { return dir == 0 ? step : (step < NCTX ? NCTX - 1 - step : RB - 1 - (step - NCTX)); }
constexpr int NCHUNK = RB / 64;
constexpr int TS = 72;
constexpr int QS = 136;

DI void unpack8(const u32x4 v, float* o) {
  o[0] = bf2f((bf16_t)(v.x & 0xffff)); o[1] = bf2f((bf16_t)(v.x >> 16)); o[2] = bf2f((bf16_t)(v.y & 0xffff)); o[3] = bf2f((bf16_t)(v.y >> 16));
  o[4] = bf2f((bf16_t)(v.z & 0xffff)); o[5] = bf2f((bf16_t)(v.z >> 16)); o[6] = bf2f((bf16_t)(v.w & 0xffff)); o[7] = bf2f((bf16_t)(v.w >> 16));
}

template <bool SSD>
struct ScanCtx {
  const bf16_t* P1; const bf16_t* XC; const float* DT;
  int dir, hh, row0, sgn; float A;
  DI size_t row(int t) const { return (size_t)(row0 + sgn * t); }
  DI const bf16_t* lf_ptr(int t, int c8) const { return P1 + row(t) * 3072 + 512 + dir * 512 + hh * 128 + c8; }
  DI const bf16_t* q_ptr(int t, int c8) const { return SSD ? XC + row(t) * 1024 + 768 + (hh >> 2) * 128 + c8 : P1 + row(t) * 3072 + hh * 128 + c8; }
  DI const bf16_t* k_ptr(int t, int c8) const { return XC + row(t) * 1024 + 512 + (hh >> 2) * 128 + c8; }
  DI const bf16_t* v_ptr(int t, int c8) const { return SSD ? XC + row(t) * 1024 + hh * 64 + c8 : P1 + row(t) * 3072 + 1536 + hh * 128 + c8; }
  DI float dt(int t) const { return DT[row(t) * 16 + dir * 8 + hh]; }
};
template <bool SSD>
DI ScanCtx<SSD> make_scan_ctx(const Params& p, int it, int dir) {
  constexpr int NH = SSD ? 8 : 4;
  ScanCtx<SSD> s;
  s.P1 = (const bf16_t*)(p.ws + OFF_P1); s.XC = (const bf16_t*)(p.ws + OFF_XC); s.DT = (const float*)(p.ws + OFF_DT);
  const int c = it % NCHUNK, bh = it / NCHUNK;
  s.hh = bh % NH; const int b = bh / NH;
  s.dir = dir;
  s.row0 = b * RB + scan_pos(dir, c * 64);
  s.sgn = dir ? -1 : 1;
  s.A = SSD ? -__expf(p.ssd_a_log[dir * 8 + s.hh]) : 0.f;
  return s;
}

template <bool SSD>
DI void stage_vt(const ScanCtx<SSD>& cx, bf16_t* VTs, const float* ACdt  , int tid) {
  if (!SSD) {
    const int vg = ((tid >> 6) << 2) | (tid & 3), tq = (tid >> 2) & 15;
    u32x4 raw[4];
#pragma unroll
    for (int i = 0; i < 4; i++) raw[i] = *(const u32x4*)cx.v_ptr(tq * 4 + i, vg * 8);
    float f[4][8];
#pragma unroll
    for (int i = 0; i < 4; i++) unpack8(raw[i], f[i]);
#pragma unroll
    for (int j = 0; j < 8; j++) {
      u32x2 o; o.x = pack2(f[0][j], f[1][j]); o.y = pack2(f[2][j], f[3][j]);
      *(u32x2*)(VTs + (vg * 8 + j) * TS + tq * 4) = o;
    }
  } else {
    const int vg = tid & 7, tq = tid >> 3;
    u32x4 raw[2];
#pragma unroll
    for (int i = 0; i < 2; i++) raw[i] = *(const u32x4*)cx.v_ptr(tq * 2 + i, vg * 8);
    float f[2][8];
#pragma unroll
    for (int i = 0; i < 2; i++) unpack8(raw[i], f[i]);
    const float d0 = ACdt[tq * 2], d1 = ACdt[tq * 2 + 1];
#pragma unroll
    for (int j = 0; j < 8; j++) *(unsigned*)(VTs + (vg * 8 + j) * TS + tq * 2) = pack2(f[0][j] * d0, f[1][j] * d1);
  }
}

template <bool SSD>
DI void ssd_decay(const ScanCtx<SSD>& cx, float* DTs, float* ACs, int tid) {
  if (tid < 64) {
    const float d = cx.dt(tid);
    float a = d * cx.A;
#pragma unroll
    for (int o = 1; o < 64; o <<= 1) { const float n = __shfl_up(a, o, 64); if (tid >= o) a += n; }
    DTs[tid] = d; ACs[tid] = a;
  }
}

DI void hgrn_prefix(const u32x4* lfraw, float lf[4][8], float bc[4][8], float* btot, float* bmid, float* seg  ,
                    float* tot  , float* mid  , int tid) {
  const int kg = ((tid >> 6) << 2) | (tid & 3), tq = (tid >> 2) & 15;
#pragma unroll
  for (int i = 0; i < 4; i++) unpack8(lfraw[i], lf[i]);
#pragma unroll
  for (int j = 0; j < 8; j++) {
    bc[0][j] = lf[0][j]; bc[1][j] = bc[0][j] + lf[1][j]; bc[2][j] = bc[1][j] + lf[2][j]; bc[3][j] = bc[2][j] + lf[3][j];
  }
  {
    float4 a, b; a.x = bc[3][0]; a.y = bc[3][1]; a.z = bc[3][2]; a.w = bc[3][3]; b.x = bc[3][4]; b.y = bc[3][5]; b.z = bc[3][6]; b.w = bc[3][7];
    *(float4*)(seg + tq * 128 + kg * 8) = a; *(float4*)(seg + tq * 128 + kg * 8 + 4) = b;
  }
  __syncthreads();
  if (tid < 128) {
    float run = 0.f;
#pragma unroll
    for (int q = 0; q < 16; q++) {
      const float tmp = seg[q * 128 + tid];
      seg[q * 128 + tid] = run;
      run += tmp;
      if (q == 7) mid[tid] = run;
    }
    tot[tid] = run;
  }
  __syncthreads();
  float base[8];
  {
    const float4 a = *(const float4*)(seg + tq * 128 + kg * 8), b = *(const float4*)(seg + tq * 128 + kg * 8 + 4);
    base[0] = a.x; base[1] = a.y; base[2] = a.z; base[3] = a.w; base[4] = b.x; base[5] = b.y; base[6] = b.z; base[7] = b.w;
    const float4 c = *(const float4*)(tot + kg * 8), d = *(const float4*)(tot + kg * 8 + 4);
    btot[0] = c.x; btot[1] = c.y; btot[2] = c.z; btot[3] = c.w; btot[4] = d.x; btot[5] = d.y; btot[6] = d.z; btot[7] = d.w;
    const float4 e = *(const float4*)(mid + kg * 8), f = *(const float4*)(mid + kg * 8 + 4);
    bmid[0] = e.x; bmid[1] = e.y; bmid[2] = e.z; bmid[3] = e.w; bmid[4] = f.x; bmid[5] = f.y; bmid[6] = f.z; bmid[7] = f.w;
  }
#pragma unroll
  for (int i = 0; i < 4; i++)
#pragma unroll
    for (int j = 0; j < 8; j++) bc[i][j] += base[j];
}

template <bool SSD>
DI void scan_passA(const Params& p, int dir, char* smem) {
  constexpr int V = SSD ? 64 : 128, NH = SSD ? 8 : 4, NIT = 2 * NH * NCHUNK, NKT = SSD ? 2 : 4;
  bf16_t* VTs = (bf16_t*)smem;
  bf16_t* K2T = VTs + 128 * TS;
  float* seg = (float*)(K2T + 128 * TS);
  float* tot = seg + 2048;
  float* mid = tot + 128;
  float* DTs = mid + 128;
  float* ACs = DTs + 64;
  bf16_t* ST = (bf16_t*)(p.ws + (SSD ? OFF_ST2 : OFF_ST));
  float* DEC = (float*)(p.ws + (SSD ? OFF_DEC2 : OFF_DEC));
  const int tid = get_tid(), lane = tid & 63, w = tid >> 6, r = lane & 31, h = lane >> 5;
  const int kg = ((tid >> 6) << 2) | (tid & 3), tq = (tid >> 2) & 15;
  for (int it = blockIdx.x; it < NIT; it += gridDim.x) {
    const ScanCtx<SSD> cx = make_scan_ctx<SSD>(p, it, dir);
    __syncthreads();
    if (!SSD) {
      u32x4 lfraw[4];
#pragma unroll
      for (int i = 0; i < 4; i++) lfraw[i] = *(const u32x4*)cx.lf_ptr(tq * 4 + i, kg * 8);
      stage_vt<SSD>(cx, VTs, nullptr, tid);
      float lf[4][8], bc[4][8], btot[8], bmid[8];
      hgrn_prefix(lfraw, lf, bc, btot, bmid, seg, tot, mid, tid);
#pragma unroll
      for (int j = 0; j < 8; j++) {
        float kv[4];
#pragma unroll
        for (int i = 0; i < 4; i++) kv[i] = (1.f - __expf(lf[i][j])) * __expf(btot[j] - bc[i][j]);
        u32x2 o; o.x = pack2(kv[0], kv[1]); o.y = pack2(kv[2], kv[3]);
        *(u32x2*)(K2T + (kg * 8 + j) * TS + tq * 4) = o;
      }
      if (tq == 0) {
        float4 a, b; a.x = __expf(btot[0]); a.y = __expf(btot[1]); a.z = __expf(btot[2]); a.w = __expf(btot[3]);
        b.x = __expf(btot[4]); b.y = __expf(btot[5]); b.z = __expf(btot[6]); b.w = __expf(btot[7]);
        *(float4*)(DEC + (size_t)it * 128 + kg * 8) = a; *(float4*)(DEC + (size_t)it * 128 + kg * 8 + 4) = b;
      }
    } else {
      u32x4 kraw[4];
#pragma unroll
      for (int i = 0; i < 4; i++) kraw[i] = *(const u32x4*)cx.k_ptr(tq * 4 + i, kg * 8);
      ssd_decay<SSD>(cx, DTs, ACs, tid);
      __syncthreads();
      stage_vt<SSD>(cx, VTs, DTs, tid);
      const float alast = ACs[63];
      float f[4][8], wgt[4];
#pragma unroll
      for (int i = 0; i < 4; i++) { unpack8(kraw[i], f[i]); wgt[i] = __expf(alast - ACs[tq * 4 + i]); }
#pragma unroll
      for (int j = 0; j < 8; j++) {
        u32x2 o; o.x = pack2(f[0][j] * wgt[0], f[1][j] * wgt[1]); o.y = pack2(f[2][j] * wgt[2], f[3][j] * wgt[3]);
        *(u32x2*)(K2T + (kg * 8 + j) * TS + tq * 4) = o;
      }
      if (tid < 128) DEC[(size_t)it * 128 + tid] = __expf(alast);
    }
    __syncthreads();
    const int vs = SSD ? (w & 1) : w, kt0 = SSD ? 2 * (w >> 1) : 0;
    f32x16 acc[NKT];
#pragma unroll
    for (int q = 0; q < NKT; q++)
#pragma unroll
      for (int e = 0; e < 16; e++) acc[q][e] = 0.f;
#pragma unroll
    for (int s = 0; s < 4; s++) {
      const bf16x8 a = *(const bf16x8*)(VTs + (vs * 32 + r) * TS + s * 16 + h * 8);
#pragma unroll
      for (int q = 0; q < NKT; q++) {
        const bf16x8 bb = *(const bf16x8*)(K2T + ((kt0 + q) * 32 + r) * TS + s * 16 + h * 8);
        acc[q] = MFMA32(bb, a, acc[q]);
      }
    }
#pragma unroll
    for (int q = 0; q < NKT; q++)
#pragma unroll
      for (int pp = 0; pp < 2; pp++) {
        const int g0 = 2 * pp, g1 = 2 * pp + 1;
        const unsigned e0 = pack2(acc[q][4 * g0], acc[q][4 * g0 + 1]), e1 = pack2(acc[q][4 * g0 + 2], acc[q][4 * g0 + 3]);
        const unsigned f0 = pack2(acc[q][4 * g1], acc[q][4 * g1 + 1]), f1 = pack2(acc[q][4 * g1 + 2], acc[q][4 * g1 + 3]);
        auto s0 = __builtin_amdgcn_permlane32_swap(e0, f0, false, false);
        auto s1 = __builtin_amdgcn_permlane32_swap(e1, f1, false, false);
        u32x4 o; o.x = s0[0]; o.y = s1[0]; o.z = s0[1]; o.w = s1[1];
        *(u32x4*)(ST + ((size_t)it * V + vs * 32 + r) * 128 + (kt0 + q) * 32 + 16 * pp + 8 * h) = o;
      }
  }
}

template <bool SSD>
DI void scan_passB(const Params& p) {
  constexpr int V = SSD ? 64 : 128, NH = SSD ? 8 : 4;
  constexpr int total = 2 * NH * V * 128;
  bf16_t* ST = (bf16_t*)(p.ws + (SSD ? OFF_ST2 : OFF_ST));
  const float* DEC = (const float*)(p.ws + (SSD ? OFF_DEC2 : OFF_DEC));
  for (int idx = blockIdx.x * 256 + get_tid(); idx < total; idx += gridDim.x * 256) {
    const int k = idx & 127, v = (idx >> 7) % V, bh = idx / (128 * V);
    bf16_t* st = ST + ((size_t)bh * NCHUNK * V + v) * 128 + k;
    const float* dc = DEC + (size_t)bh * NCHUNK * 128 + k;
    float S = 0.f;
    constexpr int G = 44;
    for (int c0 = 0; c0 < NCHUNK; c0 += G) {
      float x[G], d[G];
#pragma unroll
      for (int u = 0; u < G; u++) { x[u] = bf2f(st[(size_t)(c0 + u) * V * 128]); d[u] = dc[(size_t)(c0 + u) * 128]; }
#pragma unroll
      for (int u = 0; u < G; u++) { st[(size_t)(c0 + u) * V * 128] = f2bf(S); S = d[u] * S + x[u]; }
    }
  }
}

template <bool SSD>
DI void scan_passC(const Params& p, int dir, char* smem) {
  constexpr int V = SSD ? 64 : 128, NH = SSD ? 8 : 4, NIT = 2 * NH * NCHUNK;
  bf16_t* Qs = (bf16_t*)smem;
  bf16_t* Ks = Qs + 64 * QS;
  bf16_t* VTs = Ks + 64 * QS;
  bf16_t* Att = VTs + 128 * TS;
  float* seg = (float*)Att;
  float* tot = (float*)(Att + 64 * TS);
  float* mid = tot + 128;
  float* EM = mid + 128;
  float* DTs = EM + 128;
  const bf16_t* ST = (const bf16_t*)(p.ws + (SSD ? OFF_ST2 : OFF_ST));
  bf16_t* U = (bf16_t*)(p.ws + OFF_U);
  const int tid = get_tid(), lane = tid & 63, w = tid >> 6, r = lane & 31, h = lane >> 5;
  const int kg = ((tid >> 6) << 2) | (tid & 3), tq = (tid >> 2) & 15;
  for (int it = blockIdx.x; it < NIT; it += gridDim.x) {
    const ScanCtx<SSD> cx = make_scan_ctx<SSD>(p, it, dir);
    const int cofs = SSD ? 512 + cx.hh * 64 : cx.hh * 128;
    const int vs = SSD ? (w & 1) : w;
    __syncthreads();
    bf16x8 sf[8];
    {
      const bf16_t* sp = ST + ((size_t)it * V + vs * 32 + r) * 128 + h * 8;
#pragma unroll
      for (int s = 0; s < 8; s++) sf[s] = *(const bf16x8*)(sp + s * 16);
    }
    u32x4 qraw[4];
#pragma unroll
    for (int i = 0; i < 4; i++) qraw[i] = *(const u32x4*)cx.q_ptr(tq * 4 + i, kg * 8);
    if (!SSD) {
      u32x4 lfraw[4];
#pragma unroll
      for (int i = 0; i < 4; i++) lfraw[i] = *(const u32x4*)cx.lf_ptr(tq * 4 + i, kg * 8);
      stage_vt<SSD>(cx, VTs, nullptr, tid);
      float lf[4][8], bc[4][8], btot[8], bmid[8];
      hgrn_prefix(lfraw, lf, bc, btot, bmid, seg, tot, mid, tid);
      if (tq == 0) {
#pragma unroll
        for (int j = 0; j < 8; j++) EM[kg * 8 + j] = __expf(bmid[j]);
      }
#pragma unroll
      for (int i = 0; i < 4; i++) {
        float qf_[8], qo[8], ko[8];
        unpack8(qraw[i], qf_);
#pragma unroll
        for (int j = 0; j < 8; j++) {
          const float e = bc[i][j] - bmid[j];
          qo[j] = qf_[j] * __expf(e);
          ko[j] = (1.f - __expf(lf[i][j])) * __expf(-e);
        }
        *(u32x4*)(Qs + (tq * 4 + i) * QS + kg * 8) = pk8(qo);
        *(u32x4*)(Ks + (tq * 4 + i) * QS + kg * 8) = pk8(ko);
      }
    } else {
      u32x4 kraw[4];
#pragma unroll
      for (int i = 0; i < 4; i++) kraw[i] = *(const u32x4*)cx.k_ptr(tq * 4 + i, kg * 8);
      ssd_decay<SSD>(cx, DTs, EM, tid);
      __syncthreads();
      stage_vt<SSD>(cx, VTs, DTs, tid);
#pragma unroll
      for (int i = 0; i < 4; i++) {
        *(u32x4*)(Qs + (tq * 4 + i) * QS + kg * 8) = qraw[i];
        *(u32x4*)(Ks + (tq * 4 + i) * QS + kg * 8) = kraw[i];
      }
    }
    __syncthreads();
    {
      const int ti = w >> 1, si = w & 1;
      f32x16 acc;
#pragma unroll
      for (int e = 0; e < 16; e++) acc[e] = 0.f;
      if (w != 1) {
#pragma unroll
        for (int s = 0; s < 8; s++) {
          const bf16x8 a = *(const bf16x8*)(Qs + (ti * 32 + r) * QS + s * 16 + h * 8);
          const bf16x8 bb = *(const bf16x8*)(Ks + (si * 32 + r) * QS + s * 16 + h * 8);
          acc = MFMA32(bb, a, acc);
        }
      }
      const int t = ti * 32 + r;
      const float act = SSD ? EM[t] : 0.f;
#pragma unroll
      for (int g = 0; g < 4; g++) {
        float vv4[4];
#pragma unroll
        for (int q = 0; q < 4; q++) {
          const int sc = si * 32 + 8 * g + 4 * h + q;
          float val = acc[4 * g + q];
          if (SSD) val *= __expf(fminf(act - EM[sc], 0.f));
          vv4[q] = (sc <= t) ? val : 0.f;
        }
        u32x2 o; o.x = pack2(vv4[0], vv4[1]); o.y = pack2(vv4[2], vv4[3]);
        *(u32x2*)(Att + t * TS + si * 32 + 8 * g + 4 * h) = o;
      }
    }
    __syncthreads();
    {
      if (!SSD) {
#pragma unroll
        for (int s = 0; s < 8; s++)
#pragma unroll
          for (int j = 0; j < 8; j++) sf[s][j] = (short)f2bf(bf2f((bf16_t)sf[s][j]) * EM[s * 16 + h * 8 + j]);
      }
      constexpr int NMT = SSD ? 1 : 2;
#pragma unroll
      for (int mi = 0; mi < NMT; mi++) {
        const int i = SSD ? (w >> 1) : mi;
        f32x16 a1, a2;
#pragma unroll
        for (int e = 0; e < 16; e++) { a1[e] = 0.f; a2[e] = 0.f; }
#pragma unroll
        for (int s = 0; s < 4; s++) {
          const bf16x8 a = *(const bf16x8*)(Att + (i * 32 + r) * TS + s * 16 + h * 8);
          const bf16x8 bb = *(const bf16x8*)(VTs + (vs * 32 + r) * TS + s * 16 + h * 8);
          a1 = MFMA32(bb, a, a1);
        }
#pragma unroll
        for (int s = 0; s < 8; s++) {
          const bf16x8 a = *(const bf16x8*)(Qs + (i * 32 + r) * QS + s * 16 + h * 8);
          a2 = MFMA32(sf[s], a, a2);
        }
        const int t = i * 32 + r;
        const float sc2 = SSD ? __expf(EM[t]) : 1.f;
        bf16_t* orow = U + cx.row(t) * 1024 + cofs + vs * 32;
#pragma unroll
        for (int pp = 0; pp < 2; pp++) {
          float ve[4], vf[4];
#pragma unroll
          for (int q = 0; q < 4; q++) { ve[q] = a1[8 * pp + q] + sc2 * a2[8 * pp + q]; vf[q] = a1[8 * pp + 4 + q] + sc2 * a2[8 * pp + 4 + q]; }
          if (dir) {
            const u32x2 oe = *(const u32x2*)(orow + 16 * pp + 4 * h), of = *(const u32x2*)(orow + 16 * pp + 8 + 4 * h);
            ve[0] += bf2f((bf16_t)(oe.x & 0xffff)); ve[1] += bf2f((bf16_t)(oe.x >> 16));
            ve[2] += bf2f((bf16_t)(oe.y & 0xffff)); ve[3] += bf2f((bf16_t)(oe.y >> 16));
            vf[0] += bf2f((bf16_t)(of.x & 0xffff)); vf[1] += bf2f((bf16_t)(of.x >> 16));
            vf[2] += bf2f((bf16_t)(of.y & 0xffff)); vf[3] += bf2f((bf16_t)(of.y >> 16));
          }
          const unsigned e0 = pack2(ve[0], ve[1]), e1 = pack2(ve[2], ve[3]), f0 = pack2(vf[0], vf[1]), f1 = pack2(vf[2], vf[3]);
          auto s0 = __builtin_amdgcn_permlane32_swap(e0, f0, false, false);
          auto s1 = __builtin_amdgcn_permlane32_swap(e1, f1, false, false);
          u32x4 o; o.x = s0[0]; o.y = s1[0]; o.z = s0[1]; o.w = s1[1];
          *(u32x4*)(orow + 16 * pp + 8 * h) = o;
        }
      }
    }
  }
}

DI void rec_merge_phase(const Params& p) {
  const int lane = get_tid() & 63, w = get_tid() >> 6;
  bf16_t* Y = (bf16_t*)(p.ws + OFF_U);
  const bf16_t* P1 = (const bf16_t*)(p.ws + OFF_P1);
  const bf16_t* XC = (const bf16_t*)(p.ws + OFF_XC);
  auto ld8 = [](const bf16_t* ptr, float* o) {
    const u32x4 v = *(const u32x4*)ptr;
    const unsigned u[4] = {v.x, v.y, v.z, v.w};
#pragma unroll
    for (int j = 0; j < 4; j++) { o[2 * j] = bf2f((bf16_t)(u[j] & 0xffff)); o[2 * j + 1] = bf2f((bf16_t)(u[j] >> 16)); }
  };
  for (int row = blockIdx.x * 4 + w; row < R; row += gridDim.x * 4) {
    const int b = row_b(row), pos = row - b * RB;
    if (pos < NCTX) continue;
    const int c0 = lane * 8;
    float o[8], g[8], ysum[8], z[8], xs[8];
    ld8(Y + (size_t)row * 1024 + c0, o);
    ld8(Y + (size_t)row * 1024 + 512 + c0, ysum);
    ld8(P1 + (size_t)row * 3072 + 2048 + c0, g);
    ld8(P1 + (size_t)row * 3072 + 2560 + c0, z);
    ld8(XC + (size_t)row * 1024 + c0, xs);
    float ss = 0.f;
#pragma unroll
    for (int j = 0; j < 8; j++) ss += o[j] * o[j];
#pragma unroll
    for (int s = 8; s >= 1; s >>= 1) ss += __shfl_xor(ss, s, 64);
    float rstd = rsqrtf(ss * (1.f / 128.f) + EPS);
    u32x4 o4; unsigned ou[4];
#pragma unroll
    for (int j = 0; j < 4; j++)
      ou[j] = pack2(o[2 * j] * rstd * p.hgrn_out_norm[c0 + 2 * j] * g[2 * j], o[2 * j + 1] * rstd * p.hgrn_out_norm[c0 + 2 * j + 1] * g[2 * j + 1]);
    o4.x = ou[0]; o4.y = ou[1]; o4.z = ou[2]; o4.w = ou[3];
    const float skip = p.ssd_skip[lane >> 3];
    float y[8]; ss = 0.f;
#pragma unroll
    for (int j = 0; j < 8; j++) { y[j] = (ysum[j] + skip * xs[j]) * z[j]; ss += y[j] * y[j]; }
#pragma unroll
    for (int s = 16; s >= 1; s >>= 1) ss += __shfl_xor(ss, s, 64);
    rstd = rsqrtf(ss * (1.f / 256.f) + EPS);
    u32x4 y4;
    y4.x = pack2(y[0] * rstd * p.ssd_norm[c0], y[1] * rstd * p.ssd_norm[c0 + 1]);
    y4.y = pack2(y[2] * rstd * p.ssd_norm[c0 + 2], y[3] * rstd * p.ssd_norm[c0 + 3]);
    y4.z = pack2(y[4] * rstd * p.ssd_norm[c0 + 4], y[5] * rstd * p.ssd_norm[c0 + 5]);
    y4.w = pack2(y[6] * rstd * p.ssd_norm[c0 + 6], y[7] * rstd * p.ssd_norm[c0 + 7]);
    *(u32x4*)(Y + (size_t)row * 1024 + c0) = o4;
    *(u32x4*)(Y + (size_t)row * 1024 + 512 + c0) = y4;
  }
}

DI void final_norm_phase(const Params& p) {
  const int lane = get_tid() & 63, w = get_tid() >> 6;
  const int nrow = NB * SEQ, stride = gridDim.x * 4;
  int row = blockIdx.x * 4 + w;
  float4 v[4], vn[4];
  if (row < nrow) {
#pragma unroll
    for (int i = 0; i < 4; i++) v[i] = *(const float4*)(p.out + (size_t)row * 1024 + i * 256 + lane * 4);
  }
  for (; row < nrow; row += stride) {
    float* src = p.out + (size_t)row * 1024;
    {
      const int rn = row + stride < nrow ? row + stride : row;
#pragma unroll
      for (int i = 0; i < 4; i++) vn[i] = *(const float4*)(p.out + (size_t)rn * 1024 + i * 256 + lane * 4);
    }
    float ss = 0.f;
#pragma unroll
    for (int i = 0; i < 4; i++) ss += v[i].x * v[i].x + v[i].y * v[i].y + v[i].z * v[i].z + v[i].w * v[i].w;
    ss = wave_sum(ss);
    const float rstd = rsqrtf(ss * (1.f / 1024.f) + EPS);
#pragma unroll
    for (int i = 0; i < 4; i++) {
      const float4 g = *(const float4*)(p.final_norm + i * 256 + lane * 4);
      float4 o; o.x = v[i].x * rstd * g.x; o.y = v[i].y * rstd * g.y; o.z = v[i].z * rstd * g.z; o.w = v[i].w * rstd * g.w;
      *(float4*)(src + i * 256 + lane * 4) = o;
    }
#pragma unroll
    for (int i = 0; i < 4; i++) v[i] = vn[i];
  }
}

#define XB_TMO      128
#define XB_XCNT(j)  (256  + 64 * (j))
#define XB_XSUB(j)  (1280 + 64 * (j))
#define XB_XGEN(j)  (2304 + 64 * (j))
#define XB_TOP      3328
#define XB_TOPGEN   3392
#define XCD_BAR_WORDS 3456
#define XB_SPIN_CAP (1u << 20)
#define LAS __attribute__((address_space(3)))
DI unsigned xb_ld(unsigned* p) { return __hip_atomic_load(p, __ATOMIC_RELAXED, __HIP_MEMORY_SCOPE_AGENT); }
DI unsigned xb_add(unsigned* p, unsigned v) { return __hip_atomic_fetch_add(p, v, __ATOMIC_RELAXED, __HIP_MEMORY_SCOPE_AGENT); }
DI unsigned xb_xcc_id() { return (unsigned)__builtin_amdgcn_s_getreg((3 << 11) | 20) & 0xFu; }
#define XB_SPIN(cond, bar) do { unsigned _sp = 0; while (cond) { __builtin_amdgcn_s_sleep(1); \
    if ((++_sp & 255u) == 0u) { if (xb_ld(&(bar)[XB_TMO])) break; if (_sp > XB_SPIN_CAP) { atomicAdd(&(bar)[XB_TMO], 1u); break; } } } } while (0)
struct XcdBarrier { unsigned* bar; unsigned x; volatile LAS unsigned* st; };
DI XcdBarrier xcd_barrier_post(unsigned* bar, volatile LAS unsigned* st) {
  XcdBarrier b; b.bar = bar; b.x = xb_xcc_id(); b.st = st;
  if (get_tid() == 0) (void)xb_add(&bar[XB_XCNT(b.x)], 1u);
  return b;
}
DI void xcd_barrier_complete(unsigned* bar, unsigned x, unsigned& nloc, unsigned& nx) {
  const unsigned G = gridDim.x * gridDim.y * gridDim.z;
  unsigned sum, cnt, mine, sp = 0u;
  for (;;) {
    sum = 0u; cnt = 0u; mine = 0u;
#pragma unroll
    for (unsigned j = 0; j < 16; ++j) { const unsigned c = xb_ld(&bar[XB_XCNT(j)]); sum += c; cnt += (c > 0u) ? 1u : 0u; mine = (j == x) ? c : mine; }
    if (sum == G) break;
    __builtin_amdgcn_s_sleep(1);
    if ((++sp & 255u) == 0u) { if (xb_ld(&bar[XB_TMO])) break; if (sp > XB_SPIN_CAP) { atomicAdd(&bar[XB_TMO], 1u); break; } }
  }
  nloc = mine > 0u ? mine : 1u; nx = cnt > 0u ? cnt : 1u;
}
DI void xcd_barrier(const XcdBarrier& b) {
  asm volatile("s_waitcnt vmcnt(0)" ::: "memory");
  __syncthreads();
  if (get_tid() == 0) {
    unsigned* bar = b.bar;
    __builtin_amdgcn_s_waitcnt(0);
    unsigned nloc = b.st[0], nx = b.st[1];
    if (nloc == 0u) { xcd_barrier_complete(bar, b.x, nloc, nx); b.st[0] = nloc; b.st[1] = nx; }
    const unsigned old = xb_add(&bar[XB_XSUB(b.x)], 1u);
    const unsigned gen = old / nloc;
    if (old + 1u == (gen + 1u) * nloc) {
      __builtin_amdgcn_fence(__ATOMIC_RELEASE, "agent");
      asm volatile("s_waitcnt vmcnt(0)" ::: "memory");
      const unsigned og = xb_add(&bar[XB_TOP], 1u);
      const unsigned tg = og / nx;
      if (og + 1u == (tg + 1u) * nx) xb_add(&bar[XB_TOPGEN], 1u);
      else XB_SPIN(xb_ld(&bar[XB_TOPGEN]) == tg, bar);
      __builtin_amdgcn_fence(__ATOMIC_ACQUIRE, "agent");
      xb_add(&bar[XB_XGEN(b.x)], 1u);
      asm volatile("s_waitcnt vmcnt(0)" ::: "memory");
    } else {
      XB_SPIN(xb_ld(&bar[XB_XGEN(b.x)]) == gen, bar);
      __builtin_amdgcn_fence(__ATOMIC_ACQUIRE, "agent");
      asm volatile("s_waitcnt vmcnt(0)" ::: "memory");
    }
  }
  __syncthreads();
}

#ifndef PROBE
#define PROBE 0
#endif
#define GSYNC() do { xcd_barrier(xb); if (PROBE == 1) xcd_barrier(xb); } while (0)
DI void late_transposes(const Params& p, char* smem) {
  char* ws = p.ws;
  transpose_task(p.att_w_out, 1024, 1024, 1024, (bf16_t*)(ws + OFF_WT_ATT_OUT), (float*)smem, 388);
  transpose_task(p.rec_w_in, 1024, REC_IN, REC_IN_PAD, (bf16_t*)(ws + OFF_WT_REC_IN), (float*)smem, 485);
  transpose_task(p.rec_w_out, 1024, 1024, 1024, (bf16_t*)(ws + OFF_WT_REC_OUT), (float*)smem, 70);
  for (int l = 0; l < 2; l++) {
    transpose_task(p.w_mlp_in + (size_t)l * 1024 * 4096, 1024, 4096, 4096, (bf16_t*)(ws + (l ? OFF_WT_MLP_IN1 : OFF_WT_MLP_IN0)), (float*)smem, 167);
    transpose_task(p.w_mlp_out + (size_t)l * 4096 * 1024, 4096, 1024, 1024, (bf16_t*)(ws + (l ? OFF_WT_MLP_OUT1 : OFF_WT_MLP_OUT0)), (float*)smem, 264);
  }
  __syncthreads();
}
constexpr int SMEM_BYTES = 2 * 2 * 128 * GS * 2;
__global__ void __launch_bounds__(256, 2) mega(Params p) {
  __shared__ __attribute__((aligned(16))) char smem[SMEM_BYTES];
  __shared__ __attribute__((aligned(16))) unsigned xb_words[4];
  cg::grid_group grid = cg::this_grid();
  char* ws = p.ws;
  if (get_tid() == 0) { xb_words[0] = 0u; xb_words[1] = 0u; xb_words[2] = 0u; xb_words[3] = 0u; }
  __syncthreads();
  const XcdBarrier xb = xcd_barrier_post((unsigned*)(ws + OFF_BAR), (volatile LAS unsigned*)xb_words);
  if (PROBE == 7 && gridDim.x != 512) { for (int i = 0; i < 400; i++) __builtin_amdgcn_s_sleep(127); }
  if (p.out == nullptr) grid.sync();
  const float* modv = (const float*)(ws + OFF_MODV);
  bf16_t* U = (bf16_t*)(ws + OFF_U);
  float* hctx = (float*)(ws + OFF_HCTX);

  for (int rep = 0; rep < (PROBE == 3 ? 2 : 1); rep++) {
  for (int t = blockIdx.x; t < 384; t += gridDim.x) mod_task(p, t, (float*)smem);
  if (blockIdx.x == gridDim.x - 1) {
    float* LB = (float*)(ws + OFF_LB);
    for (int j = get_tid(); j < 1024; j += 256) LB[j] = sigmoid_f(p.hgrn_bound_logits[1024 + j] - p.hgrn_bound_logits[j]);
  }
  transpose_task(p.att_w_in, 1024, ATT_IN, ATT_IN_PAD, (bf16_t*)(ws + OFF_WT_ATT_IN), (float*)smem, 97);
  transpose_task(p.mla_w_uq, 384, 768, 768, (bf16_t*)(ws + OFF_WT_UQ), (float*)smem, 194);
  transpose_task(p.mla_w_ukv, 256, 1024, 1024, (bf16_t*)(ws + OFF_WT_UKV), (float*)smem, 291, true);
  }
  GSYNC();

  norm_mod_phase(p, 0, 0, true, false);
  if (PROBE == 6) norm_mod_phase(p, 0, 0, true, false);
  GSYNC();
  gemm_phase256(U, 1024, (const bf16_t*)(ws + OFF_WT_ATT_IN), 1024, 2048, 1024, EpiAttIn{ws}, smem);
  gemm_phase(U, 1024, (const bf16_t*)(ws + OFF_WT_ATT_IN), 1024, R, ATT_IN_PAD, 1024, 1, EpiAttIn{ws}, smem, 16);
  gemm_phase(U, 1024, (const bf16_t*)(ws + OFF_WT_ATT_IN), 1024, R, ATT_IN_PAD, 1024, 2, EpiAttIn{ws}, smem);
  GSYNC();
  att_post_phase(p);
  GSYNC();
  gemm_phase((const bf16_t*)(ws + OFF_CQ), 384, (const bf16_t*)(ws + OFF_WT_UQ), 384, R, 768, 384, false, EpiUq{ws}, smem);
  gemm_phase((const bf16_t*)(ws + OFF_CKV), 256, (const bf16_t*)(ws + OFF_WT_UKV), 256, R, 1024, 256, false, EpiUkv{ws}, smem);
  GSYNC();
  if (blockIdx.x < (gridDim.x >> 1)) late_transposes(p, smem);
  attention_phase(p, smem);
  if (blockIdx.x >= (gridDim.x >> 1)) { __syncthreads(); late_transposes(p, smem); }
  if (PROBE == 2) { __syncthreads(); attention_phase(p, smem); }
  GSYNC();
  da_merge_phase(p);
  GSYNC();
  float* ctxp = (float*)(ws + OFF_XC);
  gemm_phase256(U, 1024, (const bf16_t*)(ws + OFF_WT_ATT_OUT), 1024, 1024, 1024, EpiResid{p.x, p.ctx, p.out, hctx, modv, 2, true}, smem);
  gemm_ctx_splitk(U, 1024, (const bf16_t*)(ws + OFF_WT_ATT_OUT), 1024, 1024, ctxp, smem);
  GSYNC();
  norm_mod_phase(p, 0, 1, false, false, ctxp, 0, 2, true);
  if (PROBE == 6) norm_mod_phase(p, 0, 1, false, false);
  GSYNC();
  for (int rep = 0; rep < (PROBE == 4 ? 2 : 1); rep++)
  gemm_phase256(U, 1024, (const bf16_t*)(ws + OFF_WT_MLP_IN0), 1024, 4096, 1024, EpiMlpIn{(bf16_t*)(ws + OFF_HID)}, smem);
  gemm_phase(U, 1024, (const bf16_t*)(ws + OFF_WT_MLP_IN0), 1024, R, 4096, 1024, 2, EpiMlpIn{(bf16_t*)(ws + OFF_HID)}, smem);
  GSYNC();
  gemm_phase256((const bf16_t*)(ws + OFF_HID), 4096, (const bf16_t*)(ws + OFF_WT_MLP_OUT0), 4096, 1024, 4096, EpiResid{p.x, p.ctx, p.out, hctx, modv, 5, false}, smem);
  gemm_ctx_splitk((const bf16_t*)(ws + OFF_HID), 4096, (const bf16_t*)(ws + OFF_WT_MLP_OUT0), 4096, 4096, ctxp, smem);
  GSYNC();

  norm_mod_phase(p, 1, 0, false, false, ctxp, 0, 5);
  if (PROBE == 6) norm_mod_phase(p, 1, 0, false, false);
  GSYNC();
  gemm_phase256(U, 1024, (const bf16_t*)(ws + OFF_WT_REC_IN), 1024, 4096, 1024, EpiRecIn{ws, p.ssd_dt_bias}, smem);
  gemm_phase(U, 1024, (const bf16_t*)(ws + OFF_WT_REC_IN), 1024, R, REC_IN_PAD, 1024, 1, EpiRecIn{ws, p.ssd_dt_bias}, smem, 32);
  gemm_phase(U, 1024, (const bf16_t*)(ws + OFF_WT_REC_IN), 1024, R, REC_IN_PAD, 1024, 2, EpiRecIn{ws, p.ssd_dt_bias}, smem);
  GSYNC();
  conv_phase(p);
  if (PROBE == 6) conv_phase(p);
  GSYNC();
  scan_passA<false>(p, 0, smem); GSYNC();
  scan_passB<false>(p); scan_passA<true>(p, 0, smem); GSYNC();
  scan_passC<false>(p, 0, smem); scan_passB<true>(p); GSYNC();
  scan_passA<false>(p, 1, smem); scan_passC<true>(p, 0, smem); GSYNC();
  scan_passB<false>(p); scan_passA<true>(p, 1, smem); GSYNC();
  scan_passC<false>(p, 1, smem); scan_passB<true>(p); GSYNC();
  scan_passC<true>(p, 1, smem); GSYNC();
  rec_merge_phase(p);
  GSYNC();
  gemm_phase256(U, 1024, (const bf16_t*)(ws + OFF_WT_REC_OUT), 1024, 1024, 1024, EpiResid{p.x, p.ctx, p.out, hctx, modv + 3 * 6144, 2, false}, smem);
  GSYNC();
  norm_mod_phase(p, 1, 1, false, true);
  if (PROBE == 6) norm_mod_phase(p, 1, 1, false, true);
  GSYNC();
  gemm_phase256(U, 1024, (const bf16_t*)(ws + OFF_WT_MLP_IN1), 1024, 4096, 1024, EpiMlpIn{(bf16_t*)(ws + OFF_HID)}, smem);
  GSYNC();
  gemm_phase256((const bf16_t*)(ws + OFF_HID), 4096, (const bf16_t*)(ws + OFF_WT_MLP_OUT1), 4096, 1024, 4096, EpiResid{p.x, p.ctx, p.out, hctx, modv + 3 * 6144, 5, false}, smem);
  GSYNC();
  final_norm_phase(p);
}

extern "C" void kernel_launch(void* const* d_in, const int* in_sizes, int n_in, void* d_out, int out_size, void* d_ws, size_t ws_size,
                              hipStream_t stream) {
  static int grid_blocks = 0;
  if (!grid_blocks) {
    int dev = 0, cus = 0, per_cu = 0;
    hipGetDevice(&dev);
    hipDeviceGetAttribute(&cus, hipDeviceAttributeMultiprocessorCount, dev);
    hipOccupancyMaxActiveBlocksPerMultiprocessor(&per_cu, mega, 256, 0);
    if (per_cu < 1) per_cu = 1;
    if (per_cu > 2) per_cu = 2;
    grid_blocks = cus * per_cu;
  }
  Params p{};
  const float** f = (const float**)&p;
  for (int i = 0; i < 29; i++) f[i] = (const float*)d_in[i];
  p.out = (float*)d_out;
  p.ws = (char*)d_ws;
  hipMemsetAsync((char*)d_ws + OFF_BAR, 0, XCD_BAR_WORDS * 4, stream);
  void* args[] = {&p};
  hipError_t e = hipLaunchCooperativeKernel((void*)mega, dim3(grid_blocks), dim3(256), args, 0, stream);
  if (e != hipSuccess) fprintf(stderr, "cooperative launch failed: %s (grid %d)\n", hipGetErrorString(e), grid_blocks);
}
```

```cpp
#include <hip/hip_runtime.h>
#include <hip/hip_cooperative_groups.h>
#include <cstdio>
namespace cg = cooperative_groups;

typedef unsigned short bf16_t;
using bf16x8 = __attribute__((ext_vector_type(8))) short;
using s16x4  = __attribute__((ext_vector_type(4))) short;
using f32x16 = __attribute__((ext_vector_type(16))) float;
using u32x4 = __attribute__((ext_vector_type(4))) unsigned;
using u32x2 = __attribute__((ext_vector_type(2))) unsigned;
#define DI __device__ __forceinline__
#define MFMA32(a, b, c) __builtin_amdgcn_mfma_f32_32x32x16_bf16((a), (b), (c), 0, 0, 0)

constexpr int D = 1024, NB = 2, SEQ = 8192, NCTX = 256;
constexpr int RB = NCTX + SEQ;
constexpr int R = NB * RB;
constexpr int ATT_IN = 2208, ATT_IN_PAD = 2304;
constexpr int REC_IN = 4112, REC_IN_PAD = 4224;
constexpr int HID = 4096;
constexpr float EPS = 1e-6f;
constexpr float LOG2E = 1.4426950408889634f;

constexpr size_t SZ_WT_ATT_IN = (size_t)ATT_IN_PAD * 1024 * 2;
constexpr size_t SZ_WT_UQ = (size_t)768 * 384 * 2;
constexpr size_t SZ_WT_UKV = (size_t)1024 * 256 * 2;
constexpr size_t SZ_WT_SQ = (size_t)1024 * 1024 * 2;
constexpr size_t SZ_WT_REC_IN = (size_t)REC_IN_PAD * 1024 * 2;
constexpr size_t SZ_WT_MLP = (size_t)2 * 4096 * 1024 * 2;
constexpr size_t SZ_WT_MLP1 = (size_t)4096 * 1024 * 2;
constexpr size_t OFF_WT_REC_OUT = 0;
constexpr size_t OFF_WT_MLP_IN1 = OFF_WT_REC_OUT + SZ_WT_SQ;
constexpr size_t OFF_WT_MLP_OUT1 = OFF_WT_MLP_IN1 + SZ_WT_MLP1;
constexpr size_t OFF_U = OFF_WT_MLP_OUT1 + SZ_WT_MLP1;
constexpr size_t SZ_U = (size_t)R * 1024 * 2;
constexpr size_t OFF_MODV = OFF_U + SZ_U;
constexpr size_t SZ_MODV = (size_t)2 * 3 * 6144 * 4;
constexpr size_t OFF_LB = OFF_MODV + SZ_MODV;
constexpr size_t OFF_HCTX = OFF_LB + 4096;
constexpr size_t SZ_HCTX = (size_t)NB * NCTX * 1024 * 4;
constexpr size_t OFF_DT = OFF_HCTX + SZ_HCTX;
constexpr size_t SZ_DT = (size_t)R * 16 * 4;
constexpr size_t OFF_BIG = OFF_DT + SZ_DT;
constexpr size_t SZ_R512 = (size_t)R * 512 * 2;
constexpr size_t OFF_QDA = OFF_BIG;
constexpr size_t OFF_KDA = OFF_QDA + SZ_R512;
constexpr size_t OFF_VDAT = OFF_KDA + SZ_R512;
constexpr size_t OFF_CQ = OFF_VDAT + SZ_R512;
constexpr size_t OFF_CKV = OFF_CQ + (size_t)R * 384 * 2;
constexpr size_t OFF_KR = OFF_CKV + (size_t)R * 256 * 2;
constexpr size_t OFF_QMLA = OFF_KR + (size_t)R * 32 * 2;
constexpr size_t OFF_KMLA = OFF_QMLA + (size_t)R * 768 * 2;
constexpr size_t OFF_VMLAT = OFF_KMLA + (size_t)R * 768 * 2;
constexpr size_t OFF_OA1 = OFF_VMLAT + SZ_R512;
constexpr size_t OFF_P1 = OFF_BIG;
constexpr size_t OFF_XBC = OFF_P1 + (size_t)R * 3072 * 2;
constexpr size_t OFF_ST = OFF_XBC;
constexpr size_t OFF_XC = OFF_XBC + (size_t)R * 1024 * 2;
constexpr size_t OFF_DEC = OFF_XC + (size_t)R * 1024 * 2;
constexpr size_t OFF_DEC2 = OFF_DEC + (size_t)1056 * 128 * 4;
constexpr size_t OFF_TAIL = (OFF_DEC2 + (size_t)2112 * 128 * 4 + 255) / 256 * 256;
constexpr size_t OFF_WT_ATT_IN = OFF_TAIL;
constexpr size_t OFF_WT_UQ = OFF_WT_ATT_IN + SZ_WT_ATT_IN;
constexpr size_t OFF_WT_UKV = OFF_WT_UQ + SZ_WT_UQ;
constexpr size_t OFF_WT_ATT_OUT = OFF_WT_UKV + SZ_WT_UKV;
constexpr size_t OFF_WT_REC_IN = OFF_WT_ATT_OUT + SZ_WT_SQ;
constexpr size_t OFF_WT_MLP_IN0 = OFF_WT_REC_IN + SZ_WT_REC_IN;
constexpr size_t OFF_WT_MLP_OUT0 = OFF_WT_MLP_IN0 + SZ_WT_MLP1;
constexpr size_t OFF_END = OFF_WT_MLP_OUT0 + SZ_WT_MLP1;
constexpr size_t OFF_ST2 = OFF_TAIL;
constexpr size_t OFF_HID = OFF_BIG;
constexpr size_t OFF_BAR = (size_t)256 * 1024 * 1024 - 16384;
static_assert(OFF_END <= OFF_BAR, "workspace overflow");
static_assert(OFF_ST2 + (size_t)2112 * 64 * 128 * 2 <= OFF_BAR, "SSD state buffer does not fit behind the dead-weights tail");
static_assert(OFF_OA1 + SZ_R512 <= OFF_END, "layer0 overflow");

struct Params {
  const float *x, *c, *ctx, *c_ctx, *w_mod, *b_mod, *norm_mix, *norm_mlp, *w_mlp_in, *w_mlp_out;
  const float *att_w_in, *att_lambda, *att_subnorm, *mla_q_norm, *mla_w_uq, *mla_kv_norm, *mla_w_ukv, *att_w_out;
  const float *rec_w_in, *hgrn_bound_logits, *hgrn_out_norm, *ssd_conv_w, *ssd_conv_b, *ssd_a_log, *ssd_dt_bias;
  const float *ssd_skip, *ssd_norm, *rec_w_out, *final_norm;
  float* out;
  char* ws;
};

DI int get_tid() { int t = threadIdx.x; asm volatile("" : "+v"(t)); return t; }
DI float bf2f(bf16_t u) { return __uint_as_float(((unsigned)u) << 16); }
typedef __bf16 hbf2 __attribute__((ext_vector_type(2)));
typedef float hf2 __attribute__((ext_vector_type(2)));
DI bf16_t f2bf(float x) { __bf16 b = (__bf16)x; return __builtin_bit_cast(unsigned short, b); }
DI unsigned pack2(float a, float b) { hf2 v = {a, b}; hbf2 r = __builtin_convertvector(v, hbf2); return __builtin_bit_cast(unsigned, r); }
DI float max3f(float a, float b, float c) { float r; asm("v_max3_f32 %0, %1, %2, %3" : "=v"(r) : "v"(a), "v"(b), "v"(c)); return r; }
DI float xmax(float x) {
  const unsigned u = __float_as_uint(x);
  auto rr = __builtin_amdgcn_permlane32_swap(u, u, false, false);
  return fmaxf(__uint_as_float(rr[0]), __uint_as_float(rr[1]));
}
DI float xsum(float x) {
  const unsigned u = __float_as_uint(x);
  auto rr = __builtin_amdgcn_permlane32_swap(u, u, false, false);
  return __uint_as_float(rr[0]) + __uint_as_float(rr[1]);
}
DI float silu_f(float x) { return x / (1.f + __expf(-x)); }
DI float sigmoid_f(float x) { return 1.f / (1.f + __expf(-x)); }
DI float wave_sum(float v) {
#pragma unroll
  for (int o = 32; o >= 1; o >>= 1) v += __shfl_xor(v, o, 64);
  return v;
}
DI int row_b(int row) { return row >= RB ? 1 : 0; }

DI void transpose_task(const float* __restrict__ src, int K, int N, int Npad, bf16_t* __restrict__ dst, float* tile, int rot, bool ukv_perm = false) {
  const int tid = get_tid();
  const int tk = K / 64, tn = Npad / 64, ntile = tk * tn;
  const int nb = gridDim.x;
  for (int t0 = (blockIdx.x + rot) % nb; t0 < ntile; t0 += 2 * nb) {
    float4 v[2][4];
#pragma unroll
    for (int u = 0; u < 2; u++) {
      const int t = t0 + u * nb;
      if (t < ntile) {
        const int k0 = (t % tk) * 64, n0 = (t / tk) * 64;
#pragma unroll
        for (int i = 0; i < 4; i++) {
          const int c = tid + 256 * i, kk = c >> 4, n4 = (c & 15) * 4;
          const int n = n0 + n4;
          const float* sp = src + (size_t)(k0 + kk) * N + n;
          if (n + 3 < N) v[u][i] = *(const float4*)sp;
          else { v[u][i].x = n < N ? sp[0] : 0.f; v[u][i].y = n + 1 < N ? sp[1] : 0.f; v[u][i].z = n + 2 < N ? sp[2] : 0.f; v[u][i].w = 0.f; }
        }
      }
    }
    __syncthreads();
#pragma unroll
    for (int u = 0; u < 2; u++)
#pragma unroll
      for (int i = 0; i < 4; i++) {
        const int c = tid + 256 * i, kk = c >> 4, n4 = (c & 15) * 4;
        float* tp = tile + u * (64 * 65) + kk * 65 + n4;
        tp[0] = v[u][i].x; tp[1] = v[u][i].y; tp[2] = v[u][i].z; tp[3] = v[u][i].w;
      }
    __syncthreads();
#pragma unroll
    for (int u = 0; u < 2; u++) {
      const int t = t0 + u * nb;
      if (t < ntile) {
        const int k0 = (t % tk) * 64, n0 = (t / tk) * 64;
#pragma unroll
        for (int i = 0; i < 2; i++) {
          const int c = tid + 256 * i, nn = c >> 3, kc = (c & 7) * 8;
          const float* tp = tile + u * (64 * 65) + kc * 65 + nn;
          u32x4 o;
          o.x = pack2(tp[0], tp[65]); o.y = pack2(tp[130], tp[195]); o.z = pack2(tp[260], tp[325]); o.w = pack2(tp[390], tp[455]);
          int nd = n0 + nn;
          if (ukv_perm) { const int e = nd & 127, hh = nd >> 7; nd = e < 64 ? hh * 64 + e : 512 + hh * 64 + (e - 64); }
          *(u32x4*)(dst + (size_t)nd * K + k0 + kc) = o;
        }
      }
    }
  }
}

DI void mod_task(const Params& p, int t, float* sm) {
  const int tid = get_tid();
  float* sv = sm;
  float* red = sm + 3072;
  const int l = t / 192, n0 = (t % 192) * 32;
  __syncthreads();
  for (int i = tid; i < 3072; i += 256) {
    int which = i >> 10, k = i & 1023;
    float v = which == 0 ? p.c[k] : (which == 1 ? p.c[1024 + k] : p.c_ctx[k]);
    sv[i] = silu_f(v);
  }
  __syncthreads();
  const int col = tid & 31, kq = tid >> 5;
  const float* w = p.w_mod + (size_t)l * 1024 * 6144 + n0 + col;
  float a0 = 0.f, a1 = 0.f, a2 = 0.f;
#pragma unroll 32
  for (int k = kq * 128; k < kq * 128 + 128; k++) {
    float wv = w[(size_t)k * 6144];
    a0 += sv[k] * wv; a1 += sv[1024 + k] * wv; a2 += sv[2048 + k] * wv;
  }
  red[(kq * 3 + 0) * 32 + col] = a0; red[(kq * 3 + 1) * 32 + col] = a1; red[(kq * 3 + 2) * 32 + col] = a2;
  __syncthreads();
  if (tid < 96) {
    int i = tid >> 5, cc = tid & 31;
    float sacc = p.b_mod[l * 6144 + n0 + cc];
    for (int q = 0; q < 8; q++) sacc += red[(q * 3 + i) * 32 + cc];
    float* modv = (float*)(p.ws + OFF_MODV);
    modv[(l * 3 + i) * 6144 + n0 + cc] = sacc;
  }
}

DI void norm_mod_phase(const Params& p, int l, int which, bool from_input, bool lat_only, const float* ctxp = nullptr, int padd_l = 0, int padd_g = 0, bool ctx_base_input = false) {
  const int lane = get_tid() & 63, w = get_tid() >> 6;
  const float* modv = (const float*)(p.ws + OFF_MODV);
  const float* gain = (which == 0 ? p.norm_mix : p.norm_mlp) + l * 1024;
  bf16_t* U = (bf16_t*)(p.ws + OFF_U);
  const float* hctx = (const float*)(p.ws + OFF_HCTX);
  const int nrow = lat_only ? NB * SEQ : R, stride = gridDim.x * 4;
  auto rowof = [&](int ri) { return lat_only ? (ri >> 13) * RB + NCTX + (ri & (SEQ - 1)) : ri; };
  auto srcof = [&](int row) -> const float* {
    const int b = row_b(row), pos = row - b * RB;
    if (pos < NCTX) return ((from_input || ctx_base_input) ? p.ctx : hctx) + (size_t)(b * NCTX + pos) * 1024;
    return (from_input ? p.x : (const float*)p.out) + (size_t)(b * SEQ + pos - NCTX) * 1024;
  };
  int ri = blockIdx.x * 4 + w;
  float4 v[4], vn[4];
  if (ri < nrow) {
    const float* src = srcof(rowof(ri));
#pragma unroll
    for (int i = 0; i < 4; i++) v[i] = *(const float4*)(src + i * 256 + lane * 4);
  }
  for (; ri < nrow; ri += stride) {
    const int row = rowof(ri);
    {
      const int rn = ri + stride < nrow ? ri + stride : ri;
      const float* srcn = srcof(rowof(rn));
#pragma unroll
      for (int i = 0; i < 4; i++) vn[i] = *(const float4*)(srcn + i * 256 + lane * 4);
    }
    const int b = row_b(row), pos = row - b * RB;
    const bool isctx = pos < NCTX;
    const float* mv = modv + (size_t)(l * 3 + (isctx ? 2 : b)) * 6144;
    const float* shift = mv + (which ? 3 : 0) * 1024;
    const float* scale = mv + (which ? 4 : 1) * 1024;
    if (ctxp != nullptr && isctx) {
      const float* gate = modv + (size_t)(padd_l * 3 + 2) * 6144 + padd_g * 1024;
      const size_t crow = (size_t)(b * NCTX + pos);
      float* hc = (float*)(p.ws + OFF_HCTX) + crow * 1024;
#pragma unroll
      for (int i = 0; i < 4; i++) {
        const int cidx = i * 256 + lane * 4;
        float4 acc = *(const float4*)(ctxp + crow * 1024 + cidx);
#pragma unroll
        for (int q = 1; q < 4; q++) {
          const float4 t = *(const float4*)(ctxp + ((size_t)q * (NB * NCTX) + crow) * 1024 + cidx);
          acc.x += t.x; acc.y += t.y; acc.z += t.z; acc.w += t.w;
        }
        const float4 g4 = *(const float4*)(gate + cidx);
        v[i].x += g4.x * acc.x; v[i].y += g4.y * acc.y; v[i].z += g4.z * acc.z; v[i].w += g4.w * acc.w;
        *(float4*)(hc + cidx) = v[i];
      }
    }
    float ss = 0.f;
#pragma unroll
    for (int i = 0; i < 4; i++) ss += v[i].x * v[i].x + v[i].y * v[i].y + v[i].z * v[i].z + v[i].w * v[i].w;
    ss = wave_sum(ss);
    const float rstd = rsqrtf(ss * (1.f / 1024.f) + EPS);
#pragma unroll
    for (int i = 0; i < 4; i++) {
      int cidx = i * 256 + lane * 4;
      float4 g = *(const float4*)(gain + cidx), sh = *(const float4*)(shift + cidx), sc = *(const float4*)(scale + cidx);
      float o0 = v[i].x * rstd * g.x * (1.f + sc.x) + sh.x;
      float o1 = v[i].y * rstd * g.y * (1.f + sc.y) + sh.y;
      float o2 = v[i].z * rstd * g.z * (1.f + sc.z) + sh.z;
      float o3 = v[i].w * rstd * g.w * (1.f + sc.w) + sh.w;
      u32x2 pk; pk.x = pack2(o0, o1); pk.y = pack2(o2, o3);
      *(u32x2*)(U + (size_t)row * 1024 + cidx) = pk;
    }
#pragma unroll
    for (int i = 0; i < 4; i++) v[i] = vn[i];
  }
}

constexpr int CS = 132;
constexpr int GS = 72;
template <class Epi>
DI void gemm_tile(const bf16_t* __restrict__ A, int lda, const bf16_t* __restrict__ Bt, int ldb, int K, int m0, int n0,
                  const Epi& epi, bf16_t* sa, bf16_t* sb) {
  const int tid = get_tid(), lane = tid & 63, w = tid >> 6, r = lane & 31, h = lane >> 5;
  const int wm = w >> 1, wn = w & 1;
  f32x16 acc[2][2];
#pragma unroll
  for (int i = 0; i < 2; i++)
#pragma unroll
    for (int j = 0; j < 2; j++)
#pragma unroll
      for (int e = 0; e < 16; e++) acc[i][j][e] = 0.f;
  const int lrow = tid >> 3, lc = (tid & 7) * 8;
  const bf16_t* ga = A + (size_t)(m0 + lrow) * lda + lc;
  const bf16_t* gb = Bt + (size_t)(n0 + lrow) * ldb + lc;
  u32x4 ra[4], rb[4];
  const int nk = K >> 6;
#pragma unroll
  for (int i = 0; i < 4; i++) {
    ra[i] = *(const u32x4*)(ga + (size_t)(32 * i) * lda);
    rb[i] = *(const u32x4*)(gb + (size_t)(32 * i) * ldb);
  }
  for (int kt = 0; kt < nk; kt++) {
    bf16_t* pa = sa + (kt & 1) * (128 * GS);
    bf16_t* pb = sb + (kt & 1) * (128 * GS);
#pragma unroll
    for (int i = 0; i < 4; i++) {
      *(u32x4*)(pa + (lrow + 32 * i) * GS + lc) = ra[i];
      *(u32x4*)(pb + (lrow + 32 * i) * GS + lc) = rb[i];
    }
    __syncthreads();
    {
      const int k0 = (kt + 1 < nk ? kt + 1 : kt) << 6;
#pragma unroll
      for (int i = 0; i < 4; i++) {
        ra[i] = *(const u32x4*)(ga + (size_t)(32 * i) * lda + k0);
        rb[i] = *(const u32x4*)(gb + (size_t)(32 * i) * ldb + k0);
      }
    }
    __builtin_amdgcn_sched_barrier(0);
#pragma unroll
    for (int s = 0; s < 4; s++) {
      bf16x8 af[2], bq[2];
#pragma unroll
      for (int i = 0; i < 2; i++) af[i] = *(const bf16x8*)(pa + (wm * 64 + i * 32 + r) * GS + s * 16 + h * 8);
#pragma unroll
      for (int j = 0; j < 2; j++) bq[j] = *(const bf16x8*)(pb + (wn * 64 + j * 32 + r) * GS + s * 16 + h * 8);
#pragma unroll
      for (int i = 0; i < 2; i++)
#pragma unroll
        for (int j = 0; j < 2; j++) acc[i][j] = MFMA32(bq[j], af[i], acc[i][j]);
    }
  }
  __syncthreads();
  float* Cs = (float*)sa;
  const bool tr = epi.transposed(n0);
#pragma unroll
  for (int i = 0; i < 2; i++)
#pragma unroll
    for (int j = 0; j < 2; j++)
#pragma unroll
      for (int g = 0; g < 4; g++) {
        const int m = wm * 64 + i * 32 + r, n = wn * 64 + j * 32 + 8 * g + 4 * h;
        if (!tr) {
          float4 v; v.x = acc[i][j][4 * g]; v.y = acc[i][j][4 * g + 1]; v.z = acc[i][j][4 * g + 2]; v.w = acc[i][j][4 * g + 3];
          *(float4*)(Cs + m * CS + n) = v;
        } else {
          Cs[(n + 0) * CS + m] = acc[i][j][4 * g]; Cs[(n + 1) * CS + m] = acc[i][j][4 * g + 1];
          Cs[(n + 2) * CS + m] = acc[i][j][4 * g + 2]; Cs[(n + 3) * CS + m] = acc[i][j][4 * g + 3];
        }
      }
  __syncthreads();
  epi.store(Cs, m0, n0);
  __syncthreads();
}

template <class Epi>
DI void gemm_phase(const bf16_t* A, int lda, const bf16_t* Bt, int ldb, int M, int Npad, int K, int mode  , const Epi& epi,
                   char* smem, int ntile_lo = 0) {
  bf16_t* sa = (bf16_t*)smem;
  bf16_t* sb = sa + 2 * 128 * GS;
  const int tn = Npad / 128 - ntile_lo, tm = mode == 1 ? (NB * SEQ) / 128 : (mode == 2 ? (NB * NCTX) / 128 : M / 128);
  const int xcd = blockIdx.x & 7, rank = blockIdx.x >> 3, per = gridDim.x >> 3;
  const int mlo = (xcd * tm) >> 3, mhi = ((xcd + 1) * tm) >> 3, tmx = mhi - mlo;
  const int full = tmx >> 3, nfull = full * 8 * tn;
  for (int L = rank; L < tmx * tn; L += per) {
    int mt, nt_;
    if (L < nfull) { const int panel = L / (8 * tn), rem = L - panel * 8 * tn; nt_ = rem >> 3; mt = mlo + panel * 8 + (rem & 7); }
    else { const int rem = L - nfull, ph = tmx - full * 8; nt_ = rem / ph; mt = mlo + full * 8 + (rem - nt_ * ph); }
    const int n0 = (nt_ + ntile_lo) * 128;
    const int m0 = mode == 1 ? (mt >> 6) * RB + NCTX + (mt & 63) * 128 : (mode == 2 ? (mt >> 1) * RB + (mt & 1) * 128 : mt * 128);
    gemm_tile(A, lda, Bt, ldb, K, m0, n0, epi, sa, sb);
  }
}

DI void ld8f(const float* p, float* o) {
  const float4 a = *(const float4*)p, b = *(const float4*)(p + 4);
  o[0] = a.x; o[1] = a.y; o[2] = a.z; o[3] = a.w; o[4] = b.x; o[5] = b.y; o[6] = b.z; o[7] = b.w;
}
DI u32x4 pk8(const float* v) { u32x4 o; o.x = pack2(v[0], v[1]); o.y = pack2(v[2], v[3]); o.z = pack2(v[4], v[5]); o.w = pack2(v[6], v[7]); return o; }

struct EpiAttIn {
  char* ws;
  DI bool transposed(int n0) const { return n0 >= 1024 && n0 < 1536; }
  DI void store(const float* Cs, int m0, int n0) const {
    const int tid = get_tid();
    const int b = row_b(m0), pos0 = m0 - b * RB;
#pragma unroll 2
    for (int i = 0; i < 8; i++) {
      const int c = tid + 256 * i, row = c >> 4, ch = c & 15;
      float v[8]; ld8f(Cs + row * CS + ch * 8, v);
      const u32x4 o = pk8(v);
      if (n0 < 1024) {
        const int hh = (n0 & 511) >> 7, m = ch >> 3, d0 = (ch & 7) * 8;
        bf16_t* dst = (bf16_t*)(ws + (n0 < 512 ? OFF_QDA : OFF_KDA)) + ((size_t)((b * 2 + m) * 4 + hh) * RB + pos0 + row) * 64 + d0;
        *(u32x4*)dst = o;
      } else if (n0 < 1536) {
        const int hh = (n0 - 1024) >> 7;
        bf16_t* dst = (bf16_t*)(ws + OFF_VDAT) + ((size_t)((b * 4 + hh) * 128 + row)) * RB + pos0 + ch * 8;
        *(u32x4*)dst = o;
      } else if (n0 < 1920) {
        *(u32x4*)((bf16_t*)(ws + OFF_CQ) + (size_t)(m0 + row) * 384 + (n0 - 1536) + ch * 8) = o;
      } else if (n0 < 2176) {
        *(u32x4*)((bf16_t*)(ws + OFF_CKV) + (size_t)(m0 + row) * 256 + (n0 - 1920) + ch * 8) = o;
      } else if (ch < 4) {
        *(u32x4*)((bf16_t*)(ws + OFF_KR) + (size_t)(m0 + row) * 32 + ch * 8) = o;
      }
    }
  }
};
struct EpiUq {
  char* ws;
  DI bool transposed(int) const { return false; }
  DI void store(const float* Cs, int m0, int n0) const {
    const int tid = get_tid();
    const int b = row_b(m0), pos0 = m0 - b * RB;
#pragma unroll 2
    for (int i = 0; i < 8; i++) {
      const int c = tid + 256 * i, row = c >> 4, ch = c & 15;
      float v[8]; ld8f(Cs + row * CS + ch * 8, v);
      const int col0 = n0 + ch * 8, hh = col0 / 96, e0 = col0 - hh * 96;
      *(u32x4*)((bf16_t*)(ws + OFF_QMLA) + ((size_t)(b * 8 + hh) * RB + pos0 + row) * 96 + e0) = pk8(v);
    }
  }
};
struct EpiUkv {
  char* ws;
  DI bool transposed(int n0) const { return n0 >= 512; }
  DI void store(const float* Cs, int m0, int n0) const {
    const int tid = get_tid();
    const int b = row_b(m0), pos0 = m0 - b * RB;
#pragma unroll 2
    for (int i = 0; i < 8; i++) {
      const int c = tid + 256 * i, row = c >> 4, ch = c & 15;
      float v[8]; ld8f(Cs + row * CS + ch * 8, v);
      if (n0 < 512) {
        const int col0 = n0 + ch * 8, hh = col0 >> 6, e0 = col0 & 63;
        *(u32x4*)((bf16_t*)(ws + OFF_KMLA) + ((size_t)(b * 8 + hh) * RB + pos0 + row) * 96 + e0) = pk8(v);
      } else {
        const int nn = n0 - 512 + row, hh = nn >> 6, dv = nn & 63;
        *(u32x4*)((bf16_t*)(ws + OFF_VMLAT) + ((size_t)((b * 8 + hh) * 64 + dv)) * RB + pos0 + ch * 8) = pk8(v);
      }
    }
  }
};
struct EpiResid {
  const float* x; const float* ctx; float* hlat; float* hctx; const float* modv_l; int gidx; bool from_input;
  DI bool transposed(int) const { return false; }
  DI void store(const float* Cs, int m0, int n0) const {
    const int tid = get_tid();
    const int b = row_b(m0), pos0 = m0 - b * RB;
    const bool isctx = pos0 < NCTX;
    const float* gate = modv_l + (size_t)(isctx ? 2 : b) * 6144 + gidx * 1024 + n0;
    const float* src = isctx ? (from_input ? ctx : hctx) : (from_input ? x : hlat);
    float* dst = isctx ? hctx : hlat;
    const size_t rbase = isctx ? (size_t)(b * NCTX + pos0) : (size_t)(b * SEQ + pos0 - NCTX);
#pragma unroll 4
    for (int i = 0; i < 16; i++) {
      const int c = tid + 256 * i, row = c >> 5, ch = c & 31;
      const float4 v = *(const float4*)(Cs + row * CS + ch * 4);
      const float4 g = *(const float4*)(gate + ch * 4);
      const size_t o = (rbase + row) * 1024 + n0 + ch * 4;
      const float4 hv = *(const float4*)(src + o);
      float4 r4; r4.x = hv.x + g.x * v.x; r4.y = hv.y + g.y * v.y; r4.z = hv.z + g.z * v.z; r4.w = hv.w + g.w * v.w;
      *(float4*)(dst + o) = r4;
    }
  }
};
struct EpiCtxPartial {
  float* ctxp; int ks;
  DI bool transposed(int) const { return false; }
  DI void store(const float* Cs, int m0, int n0) const {
    const int tid = get_tid();
    const int b = row_b(m0), pos0 = m0 - b * RB;
    float* dst = ctxp + ((size_t)ks * (NB * NCTX) + (size_t)(b * NCTX + pos0)) * 1024 + n0;
#pragma unroll 4
    for (int i = 0; i < 16; i++) {
      const int c = tid + 256 * i, row = c >> 5, ch = c & 31;
      *(float4*)(dst + (size_t)row * 1024 + ch * 4) = *(const float4*)(Cs + row * CS + ch * 4);
    }
  }
};
struct EpiMlpIn {
  bf16_t* hid;
  DI bool transposed(int) const { return false; }
  DI void store(const float* Cs, int m0, int n0) const {
    const int tid = get_tid();
#pragma unroll 2
    for (int i = 0; i < 8; i++) {
      const int c = tid + 256 * i, row = c >> 4, ch = c & 15;
      float v[8]; ld8f(Cs + row * CS + ch * 8, v);
#pragma unroll
      for (int q = 0; q < 8; q++) { const float t = fmaxf(v[q], 0.f); v[q] = t * t; }
      *(u32x4*)(hid + (size_t)(m0 + row) * HID + n0 + ch * 8) = pk8(v);
    }
  }
};
struct EpiRecIn {
  char* ws; const float* dt_bias;
  DI bool transposed(int) const { return false; }
  DI void store(const float* Cs, int m0, int n0) const {
    const int tid = get_tid();
    if (n0 < 4096) {
      const int seg = n0 >> 9;
#pragma unroll 2
      for (int i = 0; i < 8; i++) {
        const int c = tid + 256 * i, row = c >> 4, ch = c & 15;
        float v[8]; ld8f(Cs + row * CS + ch * 8, v);
        if (seg == 0 || seg == 4 || seg == 5) {
#pragma unroll
          for (int q = 0; q < 8; q++) v[q] = silu_f(v[q]);
        } else if (seg == 1 || seg == 2) {
          const float* lb = (const float*)(ws + OFF_LB) + (n0 - 512) + ch * 8;
#pragma unroll
          for (int q = 0; q < 8; q++) v[q] = __logf(lb[q] + (1.f - lb[q]) * sigmoid_f(v[q]));
        }
        if (n0 < 3072) *(u32x4*)((bf16_t*)(ws + OFF_P1) + (size_t)(m0 + row) * 3072 + n0 + ch * 8) = pk8(v);
        else *(u32x4*)((bf16_t*)(ws + OFF_XBC) + (size_t)(m0 + row) * 1024 + (n0 - 3072) + ch * 8) = pk8(v);
      }
    } else {
      const int row = tid >> 1, c0 = (tid & 1) * 8;
      float* DT = (float*)(ws + OFF_DT) + (size_t)(m0 + row) * 16 + c0;
#pragma unroll
      for (int q = 0; q < 8; q++) {
        const float t = Cs[row * CS + c0 + q] + dt_bias[c0 + q];
        DT[q] = t > 20.f ? t : log1pf(__expf(t));
      }
    }
  }
};

DI void gemm_ctx_splitk(const bf16_t* A, int lda, const bf16_t* Bt, int ldb, int K, float* ctxp, char* smem) {
  bf16_t* sa = (bf16_t*)smem;
  bf16_t* sb = sa + 2 * 128 * GS;
  const int kslice = K >> 2;
  for (int u = gridDim.x - 1 - blockIdx.x; u < 128; u += gridDim.x) {
    const int ks = u & 3, t = u >> 2, nt_ = t & 7, mt = t >> 3;
    const int m0 = (mt >> 1) * RB + (mt & 1) * 128, n0 = nt_ * 128;
    gemm_tile(A + ks * kslice, lda, Bt + ks * kslice, ldb, kslice, m0, n0, EpiCtxPartial{ctxp, ks}, sa, sb);
  }
}

template <class Epi>
DI void gemm_tile256(const bf16_t* __restrict__ A, int lda, const bf16_t* __restrict__ Bt, int ldb, int K, int m0, int n0,
                     const Epi& epi, bf16_t* sa, bf16_t* sb) {
  const int tid = get_tid(), lane = tid & 63, w = tid >> 6, r = lane & 31, h = lane >> 5;
  const int wm = w >> 1, wn = w & 1;
  f32x16 acc[2][4];
#pragma unroll
  for (int i = 0; i < 2; i++)
#pragma unroll
    for (int j = 0; j < 4; j++)
#pragma unroll
      for (int e = 0; e < 16; e++) acc[i][j][e] = 0.f;
  const int lrow = tid >> 3, lc = (tid & 7) * 8;
  const bf16_t* ga = A + (size_t)(m0 + lrow) * lda + lc;
  const bf16_t* gb = Bt + (size_t)(n0 + lrow) * ldb + lc;
  u32x4 ra[4], rb[8];
  const int nk = K >> 6;
#pragma unroll
  for (int i = 0; i < 4; i++) ra[i] = *(const u32x4*)(ga + (size_t)(32 * i) * lda);
#pragma unroll
  for (int i = 0; i < 8; i++) rb[i] = *(const u32x4*)(gb + (size_t)(32 * i) * ldb);
  for (int kt = 0; kt < nk; kt++) {
    __syncthreads();
#pragma unroll
    for (int i = 0; i < 4; i++) *(u32x4*)(sa + (lrow + 32 * i) * GS + lc) = ra[i];
#pragma unroll
    for (int i = 0; i < 8; i++) *(u32x4*)(sb + (lrow + 32 * i) * GS + lc) = rb[i];
    __syncthreads();
    {
      const int k0 = (kt + 1 < nk ? kt + 1 : kt) << 6;
#pragma unroll
      for (int i = 0; i < 4; i++) ra[i] = *(const u32x4*)(ga + (size_t)(32 * i) * lda + k0);
#pragma unroll
      for (int i = 0; i < 8; i++) rb[i] = *(const u32x4*)(gb + (size_t)(32 * i) * ldb + k0);
    }
    __builtin_amdgcn_sched_barrier(0);
    __builtin_amdgcn_s_setprio(1);
#pragma unroll
    for (int s = 0; s < 4; s++) {
      bf16x8 af[2], bq[4];
#pragma unroll
      for (int i = 0; i < 2; i++) af[i] = *(const bf16x8*)(sa + (wm * 64 + i * 32 + r) * GS + s * 16 + h * 8);
#pragma unroll
      for (int j = 0; j < 4; j++) bq[j] = *(const bf16x8*)(sb + (wn * 128 + j * 32 + r) * GS + s * 16 + h * 8);
#pragma unroll
      for (int i = 0; i < 2; i++)
#pragma unroll
        for (int j = 0; j < 4; j++) acc[i][j] = MFMA32(bq[j], af[i], acc[i][j]);
    }
    __builtin_amdgcn_s_setprio(0);
  }
  float* Cs = (float*)sa;
#pragma unroll
  for (int hn = 0; hn < 2; hn++) {
    __syncthreads();
    const bool tr = epi.transposed(n0 + hn * 128);
    if (wn == hn) {
#pragma unroll
      for (int i = 0; i < 2; i++)
#pragma unroll
        for (int j = 0; j < 4; j++)
#pragma unroll
          for (int g = 0; g < 4; g++) {
            const int m = wm * 64 + i * 32 + r, n = j * 32 + 8 * g + 4 * h;
            if (!tr) {
              float4 v; v.x = acc[i][j][4 * g]; v.y = acc[i][j][4 * g + 1]; v.z = acc[i][j][4 * g + 2]; v.w = acc[i][j][4 * g + 3];
              *(float4*)(Cs + m * CS + n) = v;
            } else {
              Cs[(n + 0) * CS + m] = acc[i][j][4 * g]; Cs[(n + 1) * CS + m] = acc[i][j][4 * g + 1];
              Cs[(n + 2) * CS + m] = acc[i][j][4 * g + 2]; Cs[(n + 3) * CS + m] = acc[i][j][4 * g + 3];
            }
          }
    }
    __syncthreads();
    epi.store(Cs, m0, n0 + hn * 128);
  }
  __syncthreads();
}

using f32x4v = __attribute__((ext_vector_type(4))) float;
#define MFMA16(a, b, c) __builtin_amdgcn_mfma_f32_16x16x32_bf16((a), (b), (c), 0, 0, 0)
DI int swz(int row, int chunk) { return row * 64 + ((chunk ^ ((row >> 1) & 7)) << 3); }
template <class Epi>
DI void gemm_tile256s(const bf16_t* __restrict__ A, int lda, const bf16_t* __restrict__ Bt, int ldb, int K, int m0, int n0,
                      const Epi& epi, bf16_t* sa, bf16_t* sb) {
  const int tid = get_tid(), lane = tid & 63, w = tid >> 6, lr = lane & 15, q = lane >> 4;
  const int wm = w >> 1, wn = w & 1;
  f32x4v acc[4][8];
#pragma unroll
  for (int i = 0; i < 4; i++)
#pragma unroll
    for (int j = 0; j < 8; j++)
#pragma unroll
      for (int e = 0; e < 4; e++) acc[i][j][e] = 0.f;
  const int lrow = tid >> 3, lch = tid & 7;
  const bf16_t* ga = A + (size_t)(m0 + lrow) * lda + lch * 8;
  const bf16_t* gb = Bt + (size_t)(n0 + lrow) * ldb + lch * 8;
  u32x4 ra[4], rb[8];
  const int nk = K >> 6;
#pragma unroll
  for (int i = 0; i < 4; i++) ra[i] = *(const u32x4*)(ga + (size_t)(32 * i) * lda);
#pragma unroll
  for (int i = 0; i < 8; i++) rb[i] = *(const u32x4*)(gb + (size_t)(32 * i) * ldb);
  for (int kt = 0; kt < nk; kt++) {
    __syncthreads();
#pragma unroll
    for (int i = 0; i < 4; i++) *(u32x4*)(sa + swz(lrow + 32 * i, lch)) = ra[i];
#pragma unroll
    for (int i = 0; i < 8; i++) *(u32x4*)(sb + swz(lrow + 32 * i, lch)) = rb[i];
    __syncthreads();
    {
      const int k0 = (kt + 1 < nk ? kt + 1 : kt) << 6;
#pragma unroll
      for (int i = 0; i < 4; i++) ra[i] = *(const u32x4*)(ga + (size_t)(32 * i) * lda + k0);
#pragma unroll
      for (int i = 0; i < 8; i++) rb[i] = *(const u32x4*)(gb + (size_t)(32 * i) * ldb + k0);
    }
    __builtin_amdgcn_sched_barrier(0);
    __builtin_amdgcn_s_setprio(1);
#pragma unroll
    for (int ks = 0; ks < 2; ks++) {
      bf16x8 af[4], bq[8];
#pragma unroll
      for (int i = 0; i < 4; i++) af[i] = *(const bf16x8*)(sa + swz(wm * 64 + i * 16 + lr, ks * 4 + q));
#pragma unroll
      for (int j = 0; j < 8; j++) bq[j] = *(const bf16x8*)(sb + swz(wn * 128 + j * 16 + lr, ks * 4 + q));
#pragma unroll
      for (int i = 0; i < 4; i++)
#pragma unroll
        for (int j = 0; j < 8; j++) acc[i][j] = MFMA16(bq[j], af[i], acc[i][j]);
    }
    __builtin_amdgcn_s_setprio(0);
  }
  float* Cs = (float*)sa;
#pragma unroll
  for (int hn = 0; hn < 2; hn++) {
    __syncthreads();
    const bool tr = epi.transposed(n0 + hn * 128);
    if (wn == hn) {
#pragma unroll
      for (int i = 0; i < 4; i++)
#pragma unroll
        for (int j = 0; j < 8; j++) {
          const int m = wm * 64 + i * 16 + lr, n = j * 16 + 4 * q;
          if (!tr) {
            float4 v; v.x = acc[i][j][0]; v.y = acc[i][j][1]; v.z = acc[i][j][2]; v.w = acc[i][j][3];
            *(float4*)(Cs + m * CS + n) = v;
          } else {
            Cs[(n + 0) * CS + m] = acc[i][j][0]; Cs[(n + 1) * CS + m] = acc[i][j][1];
            Cs[(n + 2) * CS + m] = acc[i][j][2]; Cs[(n + 3) * CS + m] = acc[i][j][3];
          }
        }
    }
    __syncthreads();
    epi.store(Cs, m0, n0 + hn * 128);
  }
  __syncthreads();
}

template <class Epi>
DI void gemm_phase256(const bf16_t* A, int lda, const bf16_t* Bt, int ldb, int N, int K, const Epi& epi, char* smem) {
  bf16_t* sa = (bf16_t*)smem;
  bf16_t* sb = sa + 128 * GS;
  const int tn = N / 256, tm = (NB * SEQ) / 128;
  const int xcd = blockIdx.x & 7, rank = blockIdx.x >> 3, per = gridDim.x >> 3;
  const int mlo = (xcd * tm) >> 3, mhi = ((xcd + 1) * tm) >> 3, tmx = mhi - mlo;
  for (int L = rank; L < tmx * tn; L += per) {
    const int panel = L / (8 * tn), rem = L - panel * 8 * tn;
    const int nt_ = rem >> 3, mt = mlo + panel * 8 + (rem & 7);
    const int m0 = (mt >> 6) * RB + NCTX + (mt & 63) * 128;
    gemm_tile256s(A, lda, Bt, ldb, K, m0, nt_ * 256, epi, sa, sb);
  }
}

DI void rope_cs(int s_lat, int i, int nfreq, float& cs, float& sn) {
  const int rowp = s_lat >> 6, colp = s_lat & 63;
  const int fi = i < nfreq ? i : i - nfreq;
  const float inv = exp2f(-(float)fi / (float)nfreq * 13.287712379549449f);
  const float ang = (float)(i < nfreq ? rowp : colp) * inv;
  sn = __sinf(ang); cs = __cosf(ang);
}

DI void att_post_phase(const Params& p) {
  const int lane = get_tid() & 63, w = get_tid() >> 6;
  bf16_t* KDA = (bf16_t*)(p.ws + OFF_KDA);
  bf16_t* CQ = (bf16_t*)(p.ws + OFF_CQ);
  bf16_t* CKV = (bf16_t*)(p.ws + OFF_CKV);
  const bf16_t* KR = (const bf16_t*)(p.ws + OFF_KR);
  bf16_t* KMLA = (bf16_t*)(p.ws + OFF_KMLA);
  for (int row = blockIdx.x * 4 + w; row < R; row += gridDim.x * 4) {
    const int b = row_b(row), pos = row - b * RB;
    const bool lat = pos >= NCTX;
    const int s_lat = pos - NCTX;
    if (lat) {
#pragma unroll
      for (int q = 0; q < 4; q++) {
        const int pi = q * 64 + lane, vec = pi >> 5, i = pi & 31;
        bf16_t* kp = KDA + ((size_t)(b * 8 + vec) * RB + pos) * 64;
        float cs, sn; rope_cs(s_lat, i, 16, cs, sn);
        const float x1 = bf2f(kp[i]), x2 = bf2f(kp[i + 32]);
        kp[i] = f2bf(x1 * cs - x2 * sn);
        kp[i + 32] = f2bf(x1 * sn + x2 * cs);
      }
    }
    {
      bf16_t* cq = CQ + (size_t)row * 384;
      float v[6], ss = 0.f;
#pragma unroll
      for (int i = 0; i < 6; i++) { v[i] = bf2f(cq[i * 64 + lane]); ss += v[i] * v[i]; }
      ss = wave_sum(ss);
      const float rstd = rsqrtf(ss * (1.f / 384.f) + EPS);
#pragma unroll
      for (int i = 0; i < 6; i++) cq[i * 64 + lane] = f2bf(v[i] * rstd * p.mla_q_norm[i * 64 + lane]);
    }
    {
      bf16_t* ck = CKV + (size_t)row * 256;
      float v[4], ss = 0.f;
#pragma unroll
      for (int i = 0; i < 4; i++) { v[i] = bf2f(ck[i * 64 + lane]); ss += v[i] * v[i]; }
      ss = wave_sum(ss);
      const float rstd = rsqrtf(ss * (1.f / 256.f) + EPS);
#pragma unroll
      for (int i = 0; i < 4; i++) ck[i * 64 + lane] = f2bf(v[i] * rstd * p.mla_kv_norm[i * 64 + lane]);
    }
    {
      const bf16_t* kr = KR + (size_t)row * 32;
      const int i = lane & 15;
      const float x1 = bf2f(kr[i]), x2 = bf2f(kr[i + 16]);
      float o1 = x1, o2 = x2;
      if (lat) { float cs, sn; rope_cs(s_lat, i, 8, cs, sn); o1 = x1 * cs - x2 * sn; o2 = x1 * sn + x2 * cs; }
      const bf16_t b1 = f2bf(o1), b2 = f2bf(o2);
#pragma unroll
      for (int q = 0; q < 2; q++) {
        const int hh = (lane >> 4) + 4 * q;
        bf16_t* kd = KMLA + ((size_t)(b * 8 + hh) * RB + pos) * 96 + 64;
        kd[i] = b1; kd[i + 16] = b2;
      }
    }
  }
}

template <int DK, int DV>
DI void attn_item(const bf16_t* __restrict__ Q, const bf16_t* __restrict__ Kp, const bf16_t* __restrict__ VT, int ldv, int nkeys,
                  float sc_log2e, int s_lat0  , bf16_t* __restrict__ out, int ostride,
                  char* smem) {
  constexpr int KS = DK + 8;
  constexpr int VS = 68;
  constexpr int NKS = DK / 16;
  constexpr int ND = DV / 32;
  constexpr int KCH = (64 * DK / 8) / 256;
  constexpr int VCH = (DV * 8) / 256;
  constexpr int KBUF = 64 * KS, VBUF = DV * VS;
  bf16_t* sk = (bf16_t*)smem;
  bf16_t* sv = sk + 2 * KBUF;
  const int tid = get_tid(), lane = tid & 63, w = tid >> 6, r = lane & 31, h = lane >> 5;

  bf16x8 qf[NKS];
  const bf16_t* qrow = Q + (size_t)(w * 32 + r) * DK;
#pragma unroll
  for (int s = 0; s < NKS; s++) qf[s] = *(const bf16x8*)(qrow + s * 16 + h * 8);
  if (s_lat0 >= 0) {
    const int s_lat = s_lat0 + w * 32 + r;
    if (DK == 64) {
#pragma unroll
      for (int s = 0; s < 2; s++)
#pragma unroll
        for (int j = 0; j < 8; j++) {
          float cs, sn; rope_cs(s_lat, 16 * s + 8 * h + j, 16, cs, sn);
          const float x1 = bf2f((bf16_t)qf[s][j]), x2 = bf2f((bf16_t)qf[s + 2][j]);
          qf[s][j] = (short)f2bf((x1 * cs - x2 * sn) * sc_log2e);
          qf[s + 2][j] = (short)f2bf((x1 * sn + x2 * cs) * sc_log2e);
        }
    } else {
#pragma unroll
      for (int s = 0; s < NKS - 2; s++)
#pragma unroll
        for (int j = 0; j < 8; j++) qf[s][j] = (short)f2bf(bf2f((bf16_t)qf[s][j]) * sc_log2e);
#pragma unroll
      for (int j = 0; j < 8; j++) {
        float cs, sn; rope_cs(s_lat, 8 * h + j, 8, cs, sn);
        const float x1 = bf2f((bf16_t)qf[NKS - 2][j]), x2 = bf2f((bf16_t)qf[NKS - 1][j]);
        qf[NKS - 2][j] = (short)f2bf((x1 * cs - x2 * sn) * sc_log2e);
        qf[NKS - 1][j] = (short)f2bf((x1 * sn + x2 * cs) * sc_log2e);
      }
    }
  } else {
#pragma unroll
    for (int s = 0; s < NKS; s++)
#pragma unroll
      for (int j = 0; j < 8; j++) qf[s][j] = (short)f2bf(bf2f((bf16_t)qf[s][j]) * sc_log2e);
  }

  f32x16 O[ND];
#pragma unroll
  for (int d = 0; d < ND; d++)
#pragma unroll
    for (int e = 0; e < 16; e++) O[d][e] = 0.f;
  float m_run = 0.f;
  hf2 lsum = {0.f, 0.f};

  u32x4 rkA[KCH], rvA[VCH], rkB[KCH], rvB[VCH];
  auto gload_k = [&](int kt, u32x4* rk) {
#pragma unroll
    for (int i = 0; i < KCH; i++) {
      const int c = tid + 256 * i;
      rk[i] = *(const u32x4*)(Kp + (size_t)kt * 64 * DK + (size_t)c * 8);
    }
  };
  auto gload_v = [&](int kt, u32x4* rv) {
#pragma unroll
    for (int i = 0; i < VCH; i++) {
      const int c = tid + 256 * i, d = c >> 3, cc = c & 7;
      rv[i] = *(const u32x4*)(VT + (size_t)d * ldv + kt * 64 + cc * 8);
    }
  };
  auto stage_k = [&](bf16_t* pk, const u32x4* rk) {
#pragma unroll
    for (int i = 0; i < KCH; i++) {
      const int c = tid + 256 * i, row = c / (DK / 8), cc = c % (DK / 8);
      *(u32x4*)(pk + row * KS + cc * 8) = rk[i];
    }
  };
  auto stage_v = [&](bf16_t* pv, const u32x4* rv) {
#pragma unroll
    for (int i = 0; i < VCH; i++) {
      const int c = tid + 256 * i, d = c >> 3, cc = c & 7;
      u32x2 lo, hi; lo.x = rv[i].x; lo.y = rv[i].y; hi.x = rv[i].z; hi.y = rv[i].w;
      *(u32x2*)(pv + d * VS + cc * 8) = lo;
      *(u32x2*)(pv + d * VS + cc * 8 + 4) = hi;
    }
  };
  f32x16 negm = {0.f, 0.f, 0.f, 0.f, 0.f, 0.f, 0.f, 0.f, 0.f, 0.f, 0.f, 0.f, 0.f, 0.f, 0.f, 0.f};
  bool first = true;
  auto qk = [&](const bf16_t* pk, f32x16* S) {
    bf16x8 kf[2][NKS];
#pragma unroll
    for (int sub = 0; sub < 2; sub++)
#pragma unroll
      for (int s = 0; s < NKS; s++) kf[sub][s] = *(const bf16x8*)(pk + (sub * 32 + r) * KS + s * 16 + h * 8);
    __builtin_amdgcn_sched_barrier(0);
#pragma unroll
    for (int s = 0; s < NKS; s++)
#pragma unroll
      for (int sub = 0; sub < 2; sub++) S[sub] = MFMA32(kf[sub][s], qf[s], s == 0 ? negm : S[sub]);
  };
  const int nt = nkeys >> 6;
  auto vfrag = [&](const bf16_t* pv, int d, int q) -> bf16x8 {
    const bf16_t* vp = pv + (d * 32 + r) * VS + q * 16 + 4 * h;
    const s16x4 lo = *(const s16x4*)vp;
    const s16x4 hi = *(const s16x4*)(vp + 8);
    return __builtin_shufflevector(lo, hi, 0, 1, 2, 3, 4, 5, 6, 7);
  };
  __syncthreads();
  gload_k(0, rkA); gload_v(0, rvA);
  gload_k(1, rkB); gload_v(1, rvB);
  auto tile_body = [&](const bf16_t* pk, const bf16_t* pv) {
    f32x16 S[2];
      qk(pk, S);
      bf16x8 vf[2][4];
#pragma unroll
      for (int q = 0; q < 4; q++) vf[0][q] = vfrag(pv, 0, q);
      __builtin_amdgcn_sched_barrier(0);
      float mx = max3f(S[0][0], S[0][1], S[0][2]);
#pragma unroll
      for (int e = 3; e < 15; e += 2) mx = max3f(mx, S[0][e], S[0][e + 1]);
      mx = max3f(mx, S[0][15], S[1][0]);
#pragma unroll
      for (int e = 1; e < 15; e += 2) mx = max3f(mx, S[1][e], S[1][e + 1]);
      mx = fmaxf(mx, S[1][15]);
      mx = xmax(mx);
      const bool need = first || (mx > 6.0f);
      if (__any(need)) {
        asm volatile("; rare rescale path" ::: "memory");
        const float delta = need ? mx : 0.f;
        const float alpha = first ? 1.f : __builtin_amdgcn_exp2f(-delta);
        m_run += delta;
#pragma unroll
        for (int e = 0; e < 16; e++) negm[e] = -m_run;
#pragma unroll
        for (int sub = 0; sub < 2; sub++)
#pragma unroll
          for (int e = 0; e < 16; e++) S[sub][e] -= delta;
        lsum.x *= alpha;
#pragma unroll
        for (int d = 0; d < ND; d++)
#pragma unroll
          for (int e = 0; e < 16; e++) O[d][e] *= alpha;
      }
      first = false;
#pragma unroll
      for (int sub = 0; sub < 2; sub++)
#pragma unroll
        for (int e = 0; e < 16; e += 2) {
          const float p0 = __builtin_amdgcn_exp2f(S[sub][e]), p1 = __builtin_amdgcn_exp2f(S[sub][e + 1]);
          S[sub][e] = p0; S[sub][e + 1] = p1;
          lsum.x += p0; lsum.x += p1;
        }
      bf16x8 pb[4];
#pragma unroll
      for (int q = 0; q < 4; q++) {
        const int sub = q >> 1, s2 = q & 1;
        u32x4 t;
        t.x = pack2(S[sub][8 * s2 + 0], S[sub][8 * s2 + 1]); t.y = pack2(S[sub][8 * s2 + 2], S[sub][8 * s2 + 3]);
        t.z = pack2(S[sub][8 * s2 + 4], S[sub][8 * s2 + 5]); t.w = pack2(S[sub][8 * s2 + 6], S[sub][8 * s2 + 7]);
        pb[q] = __builtin_bit_cast(bf16x8, t);
      }
      __builtin_amdgcn_s_setprio(1);
#pragma unroll
      for (int d = 0; d < ND; d++) {
        if (d + 1 < ND) {
#pragma unroll
          for (int q = 0; q < 4; q++) vf[(d + 1) & 1][q] = vfrag(pv, d + 1, q);
        }
        __builtin_amdgcn_sched_barrier(0);
#pragma unroll
        for (int q = 0; q < 4; q++) O[d] = MFMA32(vf[d & 1][q], pb[q], O[d]);
      }
      __builtin_amdgcn_s_setprio(0);
  };
  for (int kt = 0; kt < nt; kt += 2) {
    {
      bf16_t* pk = sk; bf16_t* pv = sv;
      stage_k(pk, rkA); stage_v(pv, rvA);
      __syncthreads();
      const int kn = kt + 2 < nt ? kt + 2 : kt;
      gload_k(kn, rkA); gload_v(kn, rvA);
      __builtin_amdgcn_sched_barrier(0);
      tile_body(pk, pv);
    }
    {
      bf16_t* pk = sk + KBUF; bf16_t* pv = sv + VBUF;
      stage_k(pk, rkB); stage_v(pv, rvB);
      __syncthreads();
      const int kn = kt + 3 < nt ? kt + 3 : kt + 1;
      gload_k(kn, rkB); gload_v(kn, rvB);
      __builtin_amdgcn_sched_barrier(0);
      tile_body(pk, pv);
    }
  }
  __syncthreads();
  const float l_run = lsum.x + lsum.y;
  const float lt = xsum(l_run);
  const float inv = 1.f / lt;
  bf16_t* orow = out + (size_t)(w * 32 + r) * ostride;
#pragma unroll
  for (int d = 0; d < ND; d++)
#pragma unroll
    for (int g = 0; g < 4; g++) {
      u32x2 pk2;
      pk2.x = pack2(O[d][4 * g] * inv, O[d][4 * g + 1] * inv);
      pk2.y = pack2(O[d][4 * g + 2] * inv, O[d][4 * g + 3] * inv);
      *(u32x2*)(orow + d * 32 + 8 * g + 4 * h) = pk2;
    }
}

DI void attention_phase(const Params& p, char* smem) {
  const bf16_t* QDA = (const bf16_t*)(p.ws + OFF_QDA);
  const bf16_t* KDA = (const bf16_t*)(p.ws + OFF_KDA);
  const bf16_t* VDAT = (const bf16_t*)(p.ws + OFF_VDAT);
  const bf16_t* QMLA = (const bf16_t*)(p.ws + OFF_QMLA);
  const bf16_t* KMLA = (const bf16_t*)(p.ws + OFF_KMLA);
  const bf16_t* VMLAT = (const bf16_t*)(p.ws + OFF_VMLAT);
  bf16_t* Y = (bf16_t*)(p.ws + OFF_U);
  bf16_t* OA1 = (bf16_t*)(p.ws + OFF_OA1);
  const float da_sc = 0.125f * LOG2E;
  const float mla_sc = 0.10206207261596577f * LOG2E;
  const int xcd = blockIdx.x & 7, rank = blockIdx.x >> 3, per = gridDim.x >> 3;
  const int nlong = (per == 64) ? 4 : 0;
  for (int j = 0; j < nlong + 1 + 2048 / (int)gridDim.x + 1; j++) {
    int it;
    if (j < nlong) it = ((j * 8 + xcd) << 6) + rank;
    else { it = (nlong ? 2048 : 0) + (j - nlong) * gridDim.x + blockIdx.x; }
    if (it >= 2112) break;
    bool da, isctx; int qb, combo;
    if (it < 1024) { da = true; isctx = false; qb = it & 63; combo = it >> 6; }
    else if (it < 2048) { da = false; isctx = false; qb = it & 63; combo = (it - 1024) >> 6; }
    else if (it < 2080) { da = true; isctx = true; qb = it & 1; combo = (it - 2048) >> 1; }
    else { da = false; isctx = true; qb = it & 1; combo = (it - 2080) >> 1; }
    const int pos0 = isctx ? qb * 128 : NCTX + qb * 128;
    const int nkeys = isctx ? NCTX : RB;
    const int s_lat0 = isctx ? -1 : qb * 128;
    if (da) {
      const int hh = combo & 3, m = (combo >> 2) & 1, b = combo >> 3;
      const size_t base = (size_t)((b * 2 + m) * 4 + hh) * RB;
      const size_t grow = (size_t)b * RB + pos0;
      bf16_t* o = m == 0 ? (Y + grow * 1024 + hh * 128) : (OA1 + grow * 512 + hh * 128);
      attn_item<64, 128>(QDA + (base + pos0) * 64, KDA + base * 64, VDAT + (size_t)((b * 4 + hh) * 128) * RB, RB, nkeys, da_sc,
                         s_lat0, o, m == 0 ? 1024 : 512, smem);
    } else {
      const int hh = combo & 7, b = combo >> 3;
      const size_t base = (size_t)(b * 8 + hh) * RB;
      const size_t grow = (size_t)b * RB + pos0;
      attn_item<96, 64>(QMLA + (base + pos0) * 96, KMLA + base * 96, VMLAT + (size_t)((b * 8 + hh) * 64) * RB, RB, nkeys, mla_sc,
                        s_lat0, Y + grow * 1024 + 512 + hh * 64, 1024, smem);
    }
  }
}

DI void da_merge_phase(const Params& p) {
  const int lane = get_tid() & 63, w = get_tid() >> 6;
  bf16_t* Y = (bf16_t*)(p.ws + OFF_U);
  const bf16_t* OA1 = (const bf16_t*)(p.ws + OFF_OA1);
  const float* lp = p.att_lambda;
  const float s1 = wave_sum(lp[lane] * lp[64 + lane]);
  const float s2 = wave_sum(lp[128 + lane] * lp[192 + lane]);
  const float lam_init = 0.2f;
  const float lam = __expf(s1) - __expf(s2) + lam_init;
  float g[8];
#pragma unroll
  for (int j = 0; j < 8; j++) g[j] = p.att_subnorm[(lane & 15) * 8 + j] * (1.f - lam_init);
  for (int row = blockIdx.x * 4 + w; row < R; row += gridDim.x * 4) {
    u32x4 a = *(const u32x4*)(Y + (size_t)row * 1024 + lane * 8);
    u32x4 b4 = *(const u32x4*)(OA1 + (size_t)row * 512 + lane * 8);
    const unsigned au[4] = {a.x, a.y, a.z, a.w}, bu[4] = {b4.x, b4.y, b4.z, b4.w};
    float d[8], ss = 0.f;
#pragma unroll
    for (int j = 0; j < 4; j++) {
      d[2 * j] = bf2f((bf16_t)(au[j] & 0xffff)) - lam * bf2f((bf16_t)(bu[j] & 0xffff));
      d[2 * j + 1] = bf2f((bf16_t)(au[j] >> 16)) - lam * bf2f((bf16_t)(bu[j] >> 16));
      ss += d[2 * j] * d[2 * j] + d[2 * j + 1] * d[2 * j + 1];
    }
#pragma unroll
    for (int o = 8; o >= 1; o >>= 1) ss += __shfl_xor(ss, o, 64);
    const float rstd = rsqrtf(ss * (1.f / 128.f) + EPS);
    u32x4 o4;
    o4.x = pack2(d[0] * rstd * g[0], d[1] * rstd * g[1]);
    o4.y = pack2(d[2] * rstd * g[2], d[3] * rstd * g[3]);
    o4.z = pack2(d[4] * rstd * g[4], d[5] * rstd * g[5]);
    o4.w = pack2(d[6] * rstd * g[6], d[7] * rstd * g[7]);
    *(u32x4*)(Y + (size_t)row * 1024 + lane * 8) = o4;
  }
}

DI void conv_phase(const Params& p) {
  const bf16_t* XBC = (const bf16_t*)(p.ws + OFF_XBC);
  bf16_t* XC = (bf16_t*)(p.ws + OFF_XC);
  const int total = R * 128;
  for (int idx = blockIdx.x * 256 + get_tid(); idx < total; idx += gridDim.x * 256) {
    const int row = idx >> 7, c0 = (idx & 127) * 8;
    const int b = row_b(row), pos = row - b * RB;
    const int lo = pos < NCTX ? 0 : NCTX, hi = pos < NCTX ? NCTX : RB;
    float acc[8];
#pragma unroll
    for (int j = 0; j < 8; j++) acc[j] = p.ssd_conv_b[c0 + j];
#pragma unroll
    for (int t = 0; t < 5; t++) {
      const int pp = pos + t - 2;
      if (pp < lo || pp >= hi) continue;
      const u32x4 xv = *(const u32x4*)(XBC + (size_t)(b * RB + pp) * 1024 + c0);
      const unsigned xu[4] = {xv.x, xv.y, xv.z, xv.w};
      const float* wr = p.ssd_conv_w + t * 1024 + c0;
#pragma unroll
      for (int j = 0; j < 4; j++) {
        acc[2 * j] += wr[2 * j] * bf2f((bf16_t)(xu[j] & 0xffff));
        acc[2 * j + 1] += wr[2 * j + 1] * bf2f((bf16_t)(xu[j] >> 16));
      }
    }
    u32x4 o;
    o.x = pack2(silu_f(acc[0]), silu_f(acc[1])); o.y = pack2(silu_f(acc[2]), silu_f(acc[3]));
    o.z = pack2(silu_f(acc[4]), silu_f(acc[5])); o.w = pack2(silu_f(acc[6]), silu_f(acc[7]));
    *(u32x4*)(XC + (size_t)row * 1024 + c0) = o;
  }
}

DI int scan_pos(int dir, int step) { return dir == 0 ? step : (step < NCTX ? NCTX - 1 - step : RB - 1 - (step - NCTX)); }
constexpr int NCHUNK = RB / 64;
constexpr int TS = 72;
constexpr int QS = 136;

DI void unpack8(const u32x4 v, float* o) {
  o[0] = bf2f((bf16_t)(v.x & 0xffff)); o[1] = bf2f((bf16_t)(v.x >> 16)); o[2] = bf2f((bf16_t)(v.y & 0xffff)); o[3] = bf2f((bf16_t)(v.y >> 16));
  o[4] = bf2f((bf16_t)(v.z & 0xffff)); o[5] = bf2f((bf16_t)(v.z >> 16)); o[6] = bf2f((bf16_t)(v.w & 0xffff)); o[7] = bf2f((bf16_t)(v.w >> 16));
}

template <bool SSD>
struct ScanCtx {
  const bf16_t* P1; const bf16_t* XC; const float* DT;
  int dir, hh, row0, sgn; float A;
  DI size_t row(int t) const { return (size_t)(row0 + sgn * t); }
  DI const bf16_t* lf_ptr(int t, int c8) const { return P1 + row(t) * 3072 + 512 + dir * 512 + hh * 128 + c8; }
  DI const bf16_t* q_ptr(int t, int c8) const { return SSD ? XC + row(t) * 1024 + 768 + (hh >> 2) * 128 + c8 : P1 + row(t) * 3072 + hh * 128 + c8; }
  DI const bf16_t* k_ptr(int t, int c8) const { return XC + row(t) * 1024 + 512 + (hh >> 2) * 128 + c8; }
  DI const bf16_t* v_ptr(int t, int c8) const { return SSD ? XC + row(t) * 1024 + hh * 64 + c8 : P1 + row(t) * 3072 + 1536 + hh * 128 + c8; }
  DI float dt(int t) const { return DT[row(t) * 16 + dir * 8 + hh]; }
};
template <bool SSD>
DI ScanCtx<SSD> make_scan_ctx(const Params& p, int it, int dir) {
  constexpr int NH = SSD ? 8 : 4;
  ScanCtx<SSD> s;
  s.P1 = (const bf16_t*)(p.ws + OFF_P1); s.XC = (const bf16_t*)(p.ws + OFF_XC); s.DT = (const float*)(p.ws + OFF_DT);
  const int c = it % NCHUNK, bh = it / NCHUNK;
  s.hh = bh % NH; const int b = bh / NH;
  s.dir = dir;
  s.row0 = b * RB + scan_pos(dir, c * 64);
  s.sgn = dir ? -1 : 1;
  s.A = SSD ? -__expf(p.ssd_a_log[dir * 8 + s.hh]) : 0.f;
  return s;
}

template <bool SSD>
DI void stage_vt(const ScanCtx<SSD>& cx, bf16_t* VTs, const float* ACdt  , int tid) {
  if (!SSD) {
    const int vg = ((tid >> 6) << 2) | (tid & 3), tq = (tid >> 2) & 15;
    u32x4 raw[4];
#pragma unroll
    for (int i = 0; i < 4; i++) raw[i] = *(const u32x4*)cx.v_ptr(tq * 4 + i, vg * 8);
    float f[4][8];
#pragma unroll
    for (int i = 0; i < 4; i++) unpack8(raw[i], f[i]);
#pragma unroll
    for (int j = 0; j < 8; j++) {
      u32x2 o; o.x = pack2(f[0][j], f[1][j]); o.y = pack2(f[2][j], f[3][j]);
      *(u32x2*)(VTs + (vg * 8 + j) * TS + tq * 4) = o;
    }
  } else {
    const int vg = tid & 7, tq = tid >> 3;
    u32x4 raw[2];
#pragma unroll
    for (int i = 0; i < 2; i++) raw[i] = *(const u32x4*)cx.v_ptr(tq * 2 + i, vg * 8);
    float f[2][8];
#pragma unroll
    for (int i = 0; i < 2; i++) unpack8(raw[i], f[i]);
    const float d0 = ACdt[tq * 2], d1 = ACdt[tq * 2 + 1];
#pragma unroll
    for (int j = 0; j < 8; j++) *(unsigned*)(VTs + (vg * 8 + j) * TS + tq * 2) = pack2(f[0][j] * d0, f[1][j] * d1);
  }
}

template <bool SSD>
DI void ssd_decay(const ScanCtx<SSD>& cx, float* DTs, float* ACs, int tid) {
  if (tid < 64) {
    const float d = cx.dt(tid);
    float a = d * cx.A;
#pragma unroll
    for (int o = 1; o < 64; o <<= 1) { const float n = __shfl_up(a, o, 64); if (tid >= o) a += n; }
    DTs[tid] = d; ACs[tid] = a;
  }
}

DI void hgrn_prefix(const u32x4* lfraw, float lf[4][8], float bc[4][8], float* btot, float* bmid, float* seg  ,
                    float* tot  , float* mid  , int tid) {
  const int kg = ((tid >> 6) << 2) | (tid & 3), tq = (tid >> 2) & 15;
#pragma unroll
  for (int i = 0; i < 4; i++) unpack8(lfraw[i], lf[i]);
#pragma unroll
  for (int j = 0; j < 8; j++) {
    bc[0][j] = lf[0][j]; bc[1][j] = bc[0][j] + lf[1][j]; bc[2][j] = bc[1][j] + lf[2][j]; bc[3][j] = bc[2][j] + lf[3][j];
  }
  {
    float4 a, b; a.x = bc[3][0]; a.y = bc[3][1]; a.z = bc[3][2]; a.w = bc[3][3]; b.x = bc[3][4]; b.y = bc[3][5]; b.z = bc[3][6]; b.w = bc[3][7];
    *(float4*)(seg + tq * 128 + kg * 8) = a; *(float4*)(seg + tq * 128 + kg * 8 + 4) = b;
  }
  __syncthreads();
  if (tid < 128) {
    float run = 0.f;
#pragma unroll
    for (int q = 0; q < 16; q++) {
      const float tmp = seg[q * 128 + tid];
      seg[q * 128 + tid] = run;
      run += tmp;
      if (q == 7) mid[tid] = run;
    }
    tot[tid] = run;
  }
  __syncthreads();
  float base[8];
  {
    const float4 a = *(const float4*)(seg + tq * 128 + kg * 8), b = *(const float4*)(seg + tq * 128 + kg * 8 + 4);
    base[0] = a.x; base[1] = a.y; base[2] = a.z; base[3] = a.w; base[4] = b.x; base[5] = b.y; base[6] = b.z; base[7] = b.w;
    const float4 c = *(const float4*)(tot + kg * 8), d = *(const float4*)(tot + kg * 8 + 4);
    btot[0] = c.x; btot[1] = c.y; btot[2] = c.z; btot[3] = c.w; btot[4] = d.x; btot[5] = d.y; btot[6] = d.z; btot[7] = d.w;
    const float4 e = *(const float4*)(mid + kg * 8), f = *(const float4*)(mid + kg * 8 + 4);
    bmid[0] = e.x; bmid[1] = e.y; bmid[2] = e.z; bmid[3] = e.w; bmid[4] = f.x; bmid[5] = f.y; bmid[6] = f.z; bmid[7] = f.w;
  }
#pragma unroll
  for (int i = 0; i < 4; i++)
#pragma unroll
    for (int j = 0; j < 8; j++) bc[i][j] += base[j];
}

template <bool SSD>
DI void scan_passA(const Params& p, int dir, char* smem) {
  constexpr int V = SSD ? 64 : 128, NH = SSD ? 8 : 4, NIT = 2 * NH * NCHUNK, NKT = SSD ? 2 : 4;
  bf16_t* VTs = (bf16_t*)smem;
  bf16_t* K2T = VTs + 128 * TS;
  float* seg = (float*)(K2T + 128 * TS);
  float* tot = seg + 2048;
  float* mid = tot + 128;
  float* DTs = mid + 128;
  float* ACs = DTs + 64;
  bf16_t* ST = (bf16_t*)(p.ws + (SSD ? OFF_ST2 : OFF_ST));
  float* DEC = (float*)(p.ws + (SSD ? OFF_DEC2 : OFF_DEC));
  const int tid = get_tid(), lane = tid & 63, w = tid >> 6, r = lane & 31, h = lane >> 5;
  const int kg = ((tid >> 6) << 2) | (tid & 3), tq = (tid >> 2) & 15;
  for (int it = blockIdx.x; it < NIT; it += gridDim.x) {
    const ScanCtx<SSD> cx = make_scan_ctx<SSD>(p, it, dir);
    __syncthreads();
    if (!SSD) {
      u32x4 lfraw[4];
#pragma unroll
      for (int i = 0; i < 4; i++) lfraw[i] = *(const u32x4*)cx.lf_ptr(tq * 4 + i, kg * 8);
      stage_vt<SSD>(cx, VTs, nullptr, tid);
      float lf[4][8], bc[4][8], btot[8], bmid[8];
      hgrn_prefix(lfraw, lf, bc, btot, bmid, seg, tot, mid, tid);
#pragma unroll
      for (int j = 0; j < 8; j++) {
        float kv[4];
#pragma unroll
        for (int i = 0; i < 4; i++) kv[i] = (1.f - __expf(lf[i][j])) * __expf(btot[j] - bc[i][j]);
        u32x2 o; o.x = pack2(kv[0], kv[1]); o.y = pack2(kv[2], kv[3]);
        *(u32x2*)(K2T + (kg * 8 + j) * TS + tq * 4) = o;
      }
      if (tq == 0) {
        float4 a, b; a.x = __expf(btot[0]); a.y = __expf(btot[1]); a.z = __expf(btot[2]); a.w = __expf(btot[3]);
        b.x = __expf(btot[4]); b.y = __expf(btot[5]); b.z = __expf(btot[6]); b.w = __expf(btot[7]);
        *(float4*)(DEC + (size_t)it * 128 + kg * 8) = a; *(float4*)(DEC + (size_t)it * 128 + kg * 8 + 4) = b;
      }
    } else {
      u32x4 kraw[4];
#pragma unroll
      for (int i = 0; i < 4; i++) kraw[i] = *(const u32x4*)cx.k_ptr(tq * 4 + i, kg * 8);
      ssd_decay<SSD>(cx, DTs, ACs, tid);
      __syncthreads();
      stage_vt<SSD>(cx, VTs, DTs, tid);
      const float alast = ACs[63];
      float f[4][8], wgt[4];
#pragma unroll
      for (int i = 0; i < 4; i++) { unpack8(kraw[i], f[i]); wgt[i] = __expf(alast - ACs[tq * 4 + i]); }
#pragma unroll
      for (int j = 0; j < 8; j++) {
        u32x2 o; o.x = pack2(f[0][j] * wgt[0], f[1][j] * wgt[1]); o.y = pack2(f[2][j] * wgt[2], f[3][j] * wgt[3]);
        *(u32x2*)(K2T + (kg * 8 + j) * TS + tq * 4) = o;
      }
      if (tid < 128) DEC[(size_t)it * 128 + tid] = __expf(alast);
    }
    __syncthreads();
    const int vs = SSD ? (w & 1) : w, kt0 = SSD ? 2 * (w >> 1) : 0;
    f32x16 acc[NKT];
#pragma unroll
    for (int q = 0; q < NKT; q++)
#pragma unroll
      for (int e = 0; e < 16; e++) acc[q][e] = 0.f;
    __builtin_amdgcn_s_setprio(1);
#pragma unroll
    for (int s = 0; s < 4; s++) {
      const bf16x8 a = *(const bf16x8*)(VTs + (vs * 32 + r) * TS + s * 16 + h * 8);
#pragma unroll
      for (int q = 0; q < NKT; q++) {
        const bf16x8 bb = *(const bf16x8*)(K2T + ((kt0 + q) * 32 + r) * TS + s * 16 + h * 8);
        acc[q] = MFMA32(bb, a, acc[q]);
      }
    }
    __builtin_amdgcn_s_setprio(0);
#pragma unroll
    for (int q = 0; q < NKT; q++)
#pragma unroll
      for (int pp = 0; pp < 2; pp++) {
        const int g0 = 2 * pp, g1 = 2 * pp + 1;
        const unsigned e0 = pack2(acc[q][4 * g0], acc[q][4 * g0 + 1]), e1 = pack2(acc[q][4 * g0 + 2], acc[q][4 * g0 + 3]);
        const unsigned f0 = pack2(acc[q][4 * g1], acc[q][4 * g1 + 1]), f1 = pack2(acc[q][4 * g1 + 2], acc[q][4 * g1 + 3]);
        auto s0 = __builtin_amdgcn_permlane32_swap(e0, f0, false, false);
        auto s1 = __builtin_amdgcn_permlane32_swap(e1, f1, false, false);
        u32x4 o; o.x = s0[0]; o.y = s1[0]; o.z = s0[1]; o.w = s1[1];
        *(u32x4*)(ST + ((size_t)it * V + vs * 32 + r) * 128 + (kt0 + q) * 32 + 16 * pp + 8 * h) = o;
      }
  }
}

template <bool SSD>
DI void scan_passB(const Params& p) {
  constexpr int V = SSD ? 64 : 128, NH = SSD ? 8 : 4;
  constexpr int total = 2 * NH * V * 128;
  bf16_t* ST = (bf16_t*)(p.ws + (SSD ? OFF_ST2 : OFF_ST));
  const float* DEC = (const float*)(p.ws + (SSD ? OFF_DEC2 : OFF_DEC));
  for (int idx = blockIdx.x * 256 + get_tid(); idx < total; idx += gridDim.x * 256) {
    const int k = idx & 127, v = (idx >> 7) % V, bh = idx / (128 * V);
    bf16_t* st = ST + ((size_t)bh * NCHUNK * V + v) * 128 + k;
    const float* dc = DEC + (size_t)bh * NCHUNK * 128 + k;
    float S = 0.f;
    constexpr int G = 44;
    for (int c0 = 0; c0 < NCHUNK; c0 += G) {
      float x[G], d[G];
#pragma unroll
      for (int u = 0; u < G; u++) { x[u] = bf2f(st[(size_t)(c0 + u) * V * 128]); d[u] = dc[(size_t)(c0 + u) * 128]; }
#pragma unroll
      for (int u = 0; u < G; u++) { st[(size_t)(c0 + u) * V * 128] = f2bf(S); S = d[u] * S + x[u]; }
    }
  }
}

template <bool SSD>
DI void scan_passC(const Params& p, int dir, char* smem) {
  constexpr int V = SSD ? 64 : 128, NH = SSD ? 8 : 4, NIT = 2 * NH * NCHUNK;
  bf16_t* Qs = (bf16_t*)smem;
  bf16_t* Ks = Qs + 64 * QS;
  bf16_t* VTs = Ks + 64 * QS;
  bf16_t* Att = VTs + 128 * TS;
  float* seg = (float*)Att;
  float* tot = (float*)(Att + 64 * TS);
  float* mid = tot + 128;
  float* EM = mid + 128;
  float* DTs = EM + 128;
  const bf16_t* ST = (const bf16_t*)(p.ws + (SSD ? OFF_ST2 : OFF_ST));
  bf16_t* U = (bf16_t*)(p.ws + OFF_U);
  const int tid = get_tid(), lane = tid & 63, w = tid >> 6, r = lane & 31, h = lane >> 5;
  const int kg = ((tid >> 6) << 2) | (tid & 3), tq = (tid >> 2) & 15;
  for (int it = blockIdx.x; it < NIT; it += gridDim.x) {
    const ScanCtx<SSD> cx = make_scan_ctx<SSD>(p, it, dir);
    const int cofs = SSD ? 512 + cx.hh * 64 : cx.hh * 128;
    const int vs = SSD ? (w & 1) : w;
    __syncthreads();
    bf16x8 sf[8];
    {
      const bf16_t* sp = ST + ((size_t)it * V + vs * 32 + r) * 128 + h * 8;
#pragma unroll
      for (int s = 0; s < 8; s++) sf[s] = *(const bf16x8*)(sp + s * 16);
    }
    u32x4 qraw[4];
#pragma unroll
    for (int i = 0; i < 4; i++) qraw[i] = *(const u32x4*)cx.q_ptr(tq * 4 + i, kg * 8);
    if (!SSD) {
      u32x4 lfraw[4];
#pragma unroll
      for (int i = 0; i < 4; i++) lfraw[i] = *(const u32x4*)cx.lf_ptr(tq * 4 + i, kg * 8);
      stage_vt<SSD>(cx, VTs, nullptr, tid);
      float lf[4][8], bc[4][8], btot[8], bmid[8];
      hgrn_prefix(lfraw, lf, bc, btot, bmid, seg, tot, mid, tid);
      if (tq == 0) {
#pragma unroll
        for (int j = 0; j < 8; j++) EM[kg * 8 + j] = __expf(bmid[j]);
      }
#pragma unroll
      for (int i = 0; i < 4; i++) {
        float qf_[8], qo[8], ko[8];
        unpack8(qraw[i], qf_);
#pragma unroll
        for (int j = 0; j < 8; j++) {
          const float e = bc[i][j] - bmid[j];
          qo[j] = qf_[j] * __expf(e);
          ko[j] = (1.f - __expf(lf[i][j])) * __expf(-e);
        }
        *(u32x4*)(Qs + (tq * 4 + i) * QS + kg * 8) = pk8(qo);
        *(u32x4*)(Ks + (tq * 4 + i) * QS + kg * 8) = pk8(ko);
      }
    } else {
      u32x4 kraw[4];
#pragma unroll
      for (int i = 0; i < 4; i++) kraw[i] = *(const u32x4*)cx.k_ptr(tq * 4 + i, kg * 8);
      ssd_decay<SSD>(cx, DTs, EM, tid);
      __syncthreads();
      stage_vt<SSD>(cx, VTs, DTs, tid);
#pragma unroll
      for (int i = 0; i < 4; i++) {
        *(u32x4*)(Qs + (tq * 4 + i) * QS + kg * 8) = qraw[i];
        *(u32x4*)(Ks + (tq * 4 + i) * QS + kg * 8) = kraw[i];
      }
    }
    __syncthreads();
    {
      const int ti = w >> 1, si = w & 1;
      f32x16 acc;
#pragma unroll
      for (int e = 0; e < 16; e++) acc[e] = 0.f;
      if (w != 1) {
#pragma unroll
        for (int s = 0; s < 8; s++) {
          const bf16x8 a = *(const bf16x8*)(Qs + (ti * 32 + r) * QS + s * 16 + h * 8);
          const bf16x8 bb = *(const bf16x8*)(Ks + (si * 32 + r) * QS + s * 16 + h * 8);
          acc = MFMA32(bb, a, acc);
        }
      }
      const int t = ti * 32 + r;
      const float act = SSD ? EM[t] : 0.f;
#pragma unroll
      for (int g = 0; g < 4; g++) {
        float vv4[4];
#pragma unroll
        for (int q = 0; q < 4; q++) {
          const int sc = si * 32 + 8 * g + 4 * h + q;
          float val = acc[4 * g + q];
          if (SSD) val *= __expf(fminf(act - EM[sc], 0.f));
          vv4[q] = (sc <= t) ? val : 0.f;
        }
        u32x2 o; o.x = pack2(vv4[0], vv4[1]); o.y = pack2(vv4[2], vv4[3]);
        *(u32x2*)(Att + t * TS + si * 32 + 8 * g + 4 * h) = o;
      }
    }
    __syncthreads();
    {
      if (!SSD) {
#pragma unroll
        for (int s = 0; s < 8; s++)
#pragma unroll
          for (int j = 0; j < 8; j++) sf[s][j] = (short)f2bf(bf2f((bf16_t)sf[s][j]) * EM[s * 16 + h * 8 + j]);
      }
      constexpr int NMT = SSD ? 1 : 2;
#pragma unroll
      for (int mi = 0; mi < NMT; mi++) {
        const int i = SSD ? (w >> 1) : mi;
        f32x16 a1, a2;
#pragma unroll
        for (int e = 0; e < 16; e++) { a1[e] = 0.f; a2[e] = 0.f; }
        __builtin_amdgcn_s_setprio(1);
#pragma unroll
        for (int s = 0; s < 4; s++) {
          const bf16x8 a = *(const bf16x8*)(Att + (i * 32 + r) * TS + s * 16 + h * 8);
          const bf16x8 bb = *(const bf16x8*)(VTs + (vs * 32 + r) * TS + s * 16 + h * 8);
          a1 = MFMA32(bb, a, a1);
        }
#pragma unroll
        for (int s = 0; s < 8; s++) {
          const bf16x8 a = *(const bf16x8*)(Qs + (i * 32 + r) * QS + s * 16 + h * 8);
          a2 = MFMA32(sf[s], a, a2);
        }
        __builtin_amdgcn_s_setprio(0);
        const int t = i * 32 + r;
        const float sc2 = SSD ? __expf(EM[t]) : 1.f;
        bf16_t* orow = U + cx.row(t) * 1024 + cofs + vs * 32;
#pragma unroll
        for (int pp = 0; pp < 2; pp++) {
          float ve[4], vf[4];
#pragma unroll
          for (int q = 0; q < 4; q++) { ve[q] = a1[8 * pp + q] + sc2 * a2[8 * pp + q]; vf[q] = a1[8 * pp + 4 + q] + sc2 * a2[8 * pp + 4 + q]; }
          if (dir) {
            const u32x2 oe = *(const u32x2*)(orow + 16 * pp + 4 * h), of = *(const u32x2*)(orow + 16 * pp + 8 + 4 * h);
            ve[0] += bf2f((bf16_t)(oe.x & 0xffff)); ve[1] += bf2f((bf16_t)(oe.x >> 16));
            ve[2] += bf2f((bf16_t)(oe.y & 0xffff)); ve[3] += bf2f((bf16_t)(oe.y >> 16));
            vf[0] += bf2f((bf16_t)(of.x & 0xffff)); vf[1] += bf2f((bf16_t)(of.x >> 16));
            vf[2] += bf2f((bf16_t)(of.y & 0xffff)); vf[3] += bf2f((bf16_t)(of.y >> 16));
          }
          const unsigned e0 = pack2(ve[0], ve[1]), e1 = pack2(ve[2], ve[3]), f0 = pack2(vf[0], vf[1]), f1 = pack2(vf[2], vf[3]);
          auto s0 = __builtin_amdgcn_permlane32_swap(e0, f0, false, false);
          auto s1 = __builtin_amdgcn_permlane32_swap(e1, f1, false, false);
          u32x4 o; o.x = s0[0]; o.y = s1[0]; o.z = s0[1]; o.w = s1[1];
          *(u32x4*)(orow + 16 * pp + 8 * h) = o;
        }
      }
    }
  }
}

DI void rec_merge_phase(const Params& p) {
  const int lane = get_tid() & 63, w = get_tid() >> 6;
  bf16_t* Y = (bf16_t*)(p.ws + OFF_U);
  const bf16_t* P1 = (const bf16_t*)(p.ws + OFF_P1);
  const bf16_t* XC = (const bf16_t*)(p.ws + OFF_XC);
  auto ld8 = [](const bf16_t* ptr, float* o) {
    const u32x4 v = *(const u32x4*)ptr;
    const unsigned u[4] = {v.x, v.y, v.z, v.w};
#pragma unroll
    for (int j = 0; j < 4; j++) { o[2 * j] = bf2f((bf16_t)(u[j] & 0xffff)); o[2 * j + 1] = bf2f((bf16_t)(u[j] >> 16)); }
  };
  for (int row = blockIdx.x * 4 + w; row < R; row += gridDim.x * 4) {
    const int b = row_b(row), pos = row - b * RB;
    if (pos < NCTX) continue;
    const int c0 = lane * 8;
    float o[8], g[8], ysum[8], z[8], xs[8];
    ld8(Y + (size_t)row * 1024 + c0, o);
    ld8(Y + (size_t)row * 1024 + 512 + c0, ysum);
    ld8(P1 + (size_t)row * 3072 + 2048 + c0, g);
    ld8(P1 + (size_t)row * 3072 + 2560 + c0, z);
    ld8(XC + (size_t)row * 1024 + c0, xs);
    float ss = 0.f;
#pragma unroll
    for (int j = 0; j < 8; j++) ss += o[j] * o[j];
#pragma unroll
    for (int s = 8; s >= 1; s >>= 1) ss += __shfl_xor(ss, s, 64);
    float rstd = rsqrtf(ss * (1.f / 128.f) + EPS);
    u32x4 o4; unsigned ou[4];
#pragma unroll
    for (int j = 0; j < 4; j++)
      ou[j] = pack2(o[2 * j] * rstd * p.hgrn_out_norm[c0 + 2 * j] * g[2 * j], o[2 * j + 1] * rstd * p.hgrn_out_norm[c0 + 2 * j + 1] * g[2 * j + 1]);
    o4.x = ou[0]; o4.y = ou[1]; o4.z = ou[2]; o4.w = ou[3];
    const float skip = p.ssd_skip[lane >> 3];
    float y[8]; ss = 0.f;
#pragma unroll
    for (int j = 0; j < 8; j++) { y[j] = (ysum[j] + skip * xs[j]) * z[j]; ss += y[j] * y[j]; }
#pragma unroll
    for (int s = 16; s >= 1; s >>= 1) ss += __shfl_xor(ss, s, 64);
    rstd = rsqrtf(ss * (1.f / 256.f) + EPS);
    u32x4 y4;
    y4.x = pack2(y[0] * rstd * p.ssd_norm[c0], y[1] * rstd * p.ssd_norm[c0 + 1]);
    y4.y = pack2(y[2] * rstd * p.ssd_norm[c0 + 2], y[3] * rstd * p.ssd_norm[c0 + 3]);
    y4.z = pack2(y[4] * rstd * p.ssd_norm[c0 + 4], y[5] * rstd * p.ssd_norm[c0 + 5]);
    y4.w = pack2(y[6] * rstd * p.ssd_norm[c0 + 6], y[7] * rstd * p.ssd_norm[c0 + 7]);
    *(u32x4*)(Y + (size_t)row * 1024 + c0) = o4;
    *(u32x4*)(Y + (size_t)row * 1024 + 512 + c0) = y4;
  }
}

DI void final_norm_phase(const Params& p) {
  const int lane = get_tid() & 63, w = get_tid() >> 6;
  const int nrow = NB * SEQ, stride = gridDim.x * 4;
  int row = blockIdx.x * 4 + w;
  float4 v[4], vn[4];
  if (row < nrow) {
#pragma unroll
    for (int i = 0; i < 4; i++) v[i] = *(const float4*)(p.out + (size_t)row * 1024 + i * 256 + lane * 4);
  }
  for (; row < nrow; row += stride) {
    float* src = p.out + (size_t)row * 1024;
    {
      const int rn = row + stride < nrow ? row + stride : row;
#pragma unroll
      for (int i = 0; i < 4; i++) vn[i] = *(const float4*)(p.out + (size_t)rn * 1024 + i * 256 + lane * 4);
    }
    float ss = 0.f;
#pragma unroll
    for (int i = 0; i < 4; i++) ss += v[i].x * v[i].x + v[i].y * v[i].y + v[i].z * v[i].z + v[i].w * v[i].w;
    ss = wave_sum(ss);
    const float rstd = rsqrtf(ss * (1.f / 1024.f) + EPS);
#pragma unroll
    for (int i = 0; i < 4; i++) {
      const float4 g = *(const float4*)(p.final_norm + i * 256 + lane * 4);
      float4 o; o.x = v[i].x * rstd * g.x; o.y = v[i].y * rstd * g.y; o.z = v[i].z * rstd * g.z; o.w = v[i].w * rstd * g.w;
      *(float4*)(src + i * 256 + lane * 4) = o;
    }
#pragma unroll
    for (int i = 0; i < 4; i++) v[i] = vn[i];
  }
}

#define XB_TMO      128
#define XB_XCNT(j)  (256  + 64 * (j))
#define XB_XSUB(j)  (1280 + 64 * (j))
#define XB_XGEN(j)  (2304 + 64 * (j))
#define XB_TOP      3328
#define XB_TOPGEN   3392
#define XCD_BAR_WORDS 3456
#define XB_SPIN_CAP (1u << 20)
#define LAS __attribute__((address_space(3)))
DI unsigned xb_ld(unsigned* p) { return __hip_atomic_load(p, __ATOMIC_RELAXED, __HIP_MEMORY_SCOPE_AGENT); }
DI unsigned xb_add(unsigned* p, unsigned v) { return __hip_atomic_fetch_add(p, v, __ATOMIC_RELAXED, __HIP_MEMORY_SCOPE_AGENT); }
DI unsigned xb_xcc_id() { return (unsigned)__builtin_amdgcn_s_getreg((3 << 11) | 20) & 0xFu; }
#define XB_SPIN(cond, bar) do { unsigned _sp = 0; while (cond) { __builtin_amdgcn_s_sleep(1); \
    if ((++_sp & 255u) == 0u) { if (xb_ld(&(bar)[XB_TMO])) break; if (_sp > XB_SPIN_CAP) { atomicAdd(&(bar)[XB_TMO], 1u); break; } } } } while (0)
struct XcdBarrier { unsigned* bar; unsigned x; volatile LAS unsigned* st; };
DI XcdBarrier xcd_barrier_post(unsigned* bar, volatile LAS unsigned* st) {
  XcdBarrier b; b.bar = bar; b.x = xb_xcc_id(); b.st = st;
  if (get_tid() == 0) (void)xb_add(&bar[XB_XCNT(b.x)], 1u);
  return b;
}
DI void xcd_barrier_complete(unsigned* bar, unsigned x, unsigned& nloc, unsigned& nx) {
  const unsigned G = gridDim.x * gridDim.y * gridDim.z;
  unsigned sum, cnt, mine, sp = 0u;
  for (;;) {
    sum = 0u; cnt = 0u; mine = 0u;
#pragma unroll
    for (unsigned j = 0; j < 16; ++j) { const unsigned c = xb_ld(&bar[XB_XCNT(j)]); sum += c; cnt += (c > 0u) ? 1u : 0u; mine = (j == x) ? c : mine; }
    if (sum == G) break;
    __builtin_amdgcn_s_sleep(1);
    if ((++sp & 255u) == 0u) { if (xb_ld(&bar[XB_TMO])) break; if (sp > XB_SPIN_CAP) { atomicAdd(&bar[XB_TMO], 1u); break; } }
  }
  nloc = mine > 0u ? mine : 1u; nx = cnt > 0u ? cnt : 1u;
}
DI void xcd_barrier(const XcdBarrier& b) {
  asm volatile("s_waitcnt vmcnt(0)" ::: "memory");
  __syncthreads();
  if (get_tid() == 0) {
    unsigned* bar = b.bar;
    __builtin_amdgcn_s_waitcnt(0);
    unsigned nloc = b.st[0], nx = b.st[1];
    if (nloc == 0u) { xcd_barrier_complete(bar, b.x, nloc, nx); b.st[0] = nloc; b.st[1] = nx; }
    const unsigned old = xb_add(&bar[XB_XSUB(b.x)], 1u);
    const unsigned gen = old / nloc;
    if (old + 1u == (gen + 1u) * nloc) {
      __builtin_amdgcn_fence(__ATOMIC_RELEASE, "agent");
      asm volatile("s_waitcnt vmcnt(0)" ::: "memory");
      const unsigned og = xb_add(&bar[XB_TOP], 1u);
      const unsigned tg = og / nx;
      if (og + 1u == (tg + 1u) * nx) xb_add(&bar[XB_TOPGEN], 1u);
      else XB_SPIN(xb_ld(&bar[XB_TOPGEN]) == tg, bar);
      __builtin_amdgcn_fence(__ATOMIC_ACQUIRE, "agent");
      xb_add(&bar[XB_XGEN(b.x)], 1u);
      asm volatile("s_waitcnt vmcnt(0)" ::: "memory");
    } else {
      XB_SPIN(xb_ld(&bar[XB_XGEN(b.x)]) == gen, bar);
      __builtin_amdgcn_fence(__ATOMIC_ACQUIRE, "agent");
      asm volatile("s_waitcnt vmcnt(0)" ::: "memory");
    }
  }
  __syncthreads();
}

#ifndef PROBE
#define PROBE 0
#endif
#define GSYNC() do { xcd_barrier(xb); if (PROBE == 1) xcd_barrier(xb); } while (0)
DI void late_transposes(const Params& p, char* smem) {
  char* ws = p.ws;
  transpose_task(p.att_w_out, 1024, 1024, 1024, (bf16_t*)(ws + OFF_WT_ATT_OUT), (float*)smem, 388);
  transpose_task(p.rec_w_in, 1024, REC_IN, REC_IN_PAD, (bf16_t*)(ws + OFF_WT_REC_IN), (float*)smem, 485);
  transpose_task(p.rec_w_out, 1024, 1024, 1024, (bf16_t*)(ws + OFF_WT_REC_OUT), (float*)smem, 70);
  for (int l = 0; l < 2; l++) {
    transpose_task(p.w_mlp_in + (size_t)l * 1024 * 4096, 1024, 4096, 4096, (bf16_t*)(ws + (l ? OFF_WT_MLP_IN1 : OFF_WT_MLP_IN0)), (float*)smem, 167);
    transpose_task(p.w_mlp_out + (size_t)l * 4096 * 1024, 4096, 1024, 1024, (bf16_t*)(ws + (l ? OFF_WT_MLP_OUT1 : OFF_WT_MLP_OUT0)), (float*)smem, 264);
  }
  __syncthreads();
}
constexpr int SMEM_BYTES = 2 * 2 * 128 * GS * 2;
__global__ void __launch_bounds__(256, 2) mega(Params p) {
  __shared__ __attribute__((aligned(16))) char smem[SMEM_BYTES];
  __shared__ __attribute__((aligned(16))) unsigned xb_words[4];
  cg::grid_group grid = cg::this_grid();
  char* ws = p.ws;
  if (get_tid() == 0) { xb_words[0] = 0u; xb_words[1] = 0u; xb_words[2] = 0u; xb_words[3] = 0u; }
  __syncthreads();
  const XcdBarrier xb = xcd_barrier_post((unsigned*)(ws + OFF_BAR), (volatile LAS unsigned*)xb_words);
  if (PROBE == 7 && gridDim.x != 512) { for (int i = 0; i < 400; i++) __builtin_amdgcn_s_sleep(127); }
  if (p.out == nullptr) grid.sync();
  const float* modv = (const float*)(ws + OFF_MODV);
  bf16_t* U = (bf16_t*)(ws + OFF_U);
  float* hctx = (float*)(ws + OFF_HCTX);

  for (int rep = 0; rep < (PROBE == 3 ? 2 : 1); rep++) {
  for (int t = blockIdx.x; t < 384; t += gridDim.x) mod_task(p, t, (float*)smem);
  if (blockIdx.x == gridDim.x - 1) {
    float* LB = (float*)(ws + OFF_LB);
    for (int j = get_tid(); j < 1024; j += 256) LB[j] = sigmoid_f(p.hgrn_bound_logits[1024 + j] - p.hgrn_bound_logits[j]);
  }
  transpose_task(p.att_w_in, 1024, ATT_IN, ATT_IN_PAD, (bf16_t*)(ws + OFF_WT_ATT_IN), (float*)smem, 97);
  transpose_task(p.mla_w_uq, 384, 768, 768, (bf16_t*)(ws + OFF_WT_UQ), (float*)smem, 194);
  transpose_task(p.mla_w_ukv, 256, 1024, 1024, (bf16_t*)(ws + OFF_WT_UKV), (float*)smem, 291, true);
  }
  GSYNC();

  norm_mod_phase(p, 0, 0, true, false);
  if (PROBE == 6) norm_mod_phase(p, 0, 0, true, false);
  GSYNC();
  gemm_phase256(U, 1024, (const bf16_t*)(ws + OFF_WT_ATT_IN), 1024, 2048, 1024, EpiAttIn{ws}, smem);
  gemm_phase(U, 1024, (const bf16_t*)(ws + OFF_WT_ATT_IN), 1024, R, ATT_IN_PAD, 1024, 1, EpiAttIn{ws}, smem, 16);
  gemm_phase(U, 1024, (const bf16_t*)(ws + OFF_WT_ATT_IN), 1024, R, ATT_IN_PAD, 1024, 2, EpiAttIn{ws}, smem);
  GSYNC();
  att_post_phase(p);
  GSYNC();
  gemm_phase((const bf16_t*)(ws + OFF_CQ), 384, (const bf16_t*)(ws + OFF_WT_UQ), 384, R, 768, 384, false, EpiUq{ws}, smem);
  gemm_phase((const bf16_t*)(ws + OFF_CKV), 256, (const bf16_t*)(ws + OFF_WT_UKV), 256, R, 1024, 256, false, EpiUkv{ws}, smem);
  GSYNC();
  if (blockIdx.x < (gridDim.x >> 1)) late_transposes(p, smem);
  attention_phase(p, smem);
  if (blockIdx.x >= (gridDim.x >> 1)) { __syncthreads(); late_transposes(p, smem); }
  if (PROBE == 2) { __syncthreads(); attention_phase(p, smem); }
  GSYNC();
  da_merge_phase(p);
  GSYNC();
  float* ctxp = (float*)(ws + OFF_XC);
  gemm_phase256(U, 1024, (const bf16_t*)(ws + OFF_WT_ATT_OUT), 1024, 1024, 1024, EpiResid{p.x, p.ctx, p.out, hctx, modv, 2, true}, smem);
  gemm_ctx_splitk(U, 1024, (const bf16_t*)(ws + OFF_WT_ATT_OUT), 1024, 1024, ctxp, smem);
  GSYNC();
  norm_mod_phase(p, 0, 1, false, false, ctxp, 0, 2, true);
  if (PROBE == 6) norm_mod_phase(p, 0, 1, false, false);
  GSYNC();
  for (int rep = 0; rep < (PROBE == 4 ? 2 : 1); rep++)
  gemm_phase256(U, 1024, (const bf16_t*)(ws + OFF_WT_MLP_IN0), 1024, 4096, 1024, EpiMlpIn{(bf16_t*)(ws + OFF_HID)}, smem);
  gemm_phase(U, 1024, (const bf16_t*)(ws + OFF_WT_MLP_IN0), 1024, R, 4096, 1024, 2, EpiMlpIn{(bf16_t*)(ws + OFF_HID)}, smem);
  GSYNC();
  gemm_phase256((const bf16_t*)(ws + OFF_HID), 4096, (const bf16_t*)(ws + OFF_WT_MLP_OUT0), 4096, 1024, 4096, EpiResid{p.x, p.ctx, p.out, hctx, modv, 5, false}, smem);
  gemm_ctx_splitk((const bf16_t*)(ws + OFF_HID), 4096, (const bf16_t*)(ws + OFF_WT_MLP_OUT0), 4096, 4096, ctxp, smem);
  GSYNC();

  norm_mod_phase(p, 1, 0, false, false, ctxp, 0, 5);
  if (PROBE == 6) norm_mod_phase(p, 1, 0, false, false);
  GSYNC();
  gemm_phase256(U, 1024, (const bf16_t*)(ws + OFF_WT_REC_IN), 1024, 4096, 1024, EpiRecIn{ws, p.ssd_dt_bias}, smem);
  gemm_phase(U, 1024, (const bf16_t*)(ws + OFF_WT_REC_IN), 1024, R, REC_IN_PAD, 1024, 1, EpiRecIn{ws, p.ssd_dt_bias}, smem, 32);
  gemm_phase(U, 1024, (const bf16_t*)(ws + OFF_WT_REC_IN), 1024, R, REC_IN_PAD, 1024, 2, EpiRecIn{ws, p.ssd_dt_bias}, smem);
  GSYNC();
  conv_phase(p);
  if (PROBE == 6) conv_phase(p);
  GSYNC();
  scan_passA<false>(p, 0, smem); GSYNC();
  scan_passB<false>(p); scan_passA<true>(p, 0, smem); GSYNC();
  scan_passC<false>(p, 0, smem); scan_passB<true>(p); GSYNC();
  scan_passA<false>(p, 1, smem); scan_passC<true>(p, 0, smem); GSYNC();
  scan_passB<false>(p); scan_passA<true>(p, 1, smem); GSYNC();
  scan_passC<false>(p, 1, smem); scan_passB<true>(p); GSYNC();
  scan_passC<true>(p, 1, smem); GSYNC();
  rec_merge_phase(p);
  GSYNC();
  gemm_phase256(U, 1024, (const bf16_t*)(ws + OFF_WT_REC_OUT), 1024, 1024, 1024, EpiResid{p.x, p.ctx, p.out, hctx, modv + 3 * 6144, 2, false}, smem);
  GSYNC();
  norm_mod_phase(p, 1, 1, false, true);
  if (PROBE == 6) norm_mod_phase(p, 1, 1, false, true);
  GSYNC();
  gemm_phase256(U, 1024, (const bf16_t*)(ws + OFF_WT_MLP_IN1), 1024, 4096, 1024, EpiMlpIn{(bf16_t*)(ws + OFF_HID)}, smem);
  GSYNC();
  gemm_phase256((const bf16_t*)(ws + OFF_HID), 4096, (const bf16_t*)(ws + OFF_WT_MLP_OUT1), 4096, 1024, 4096, EpiResid{p.x, p.ctx, p.out, hctx, modv + 3 * 6144, 5, false}, smem);
  GSYNC();
  final_norm_phase(p);
}

extern "C" void kernel_launch(void* const* d_in, const int* in_sizes, int n_in, void* d_out, int out_size, void* d_ws, size_t ws_size,
                              hipStream_t stream) {
  static int grid_blocks = 0;
  if (!grid_blocks) {
    int dev = 0, cus = 0, per_cu = 0;
    hipGetDevice(&dev);
    hipDeviceGetAttribute(&cus, hipDeviceAttributeMultiprocessorCount, dev);
    hipOccupancyMaxActiveBlocksPerMultiprocessor(&per_cu, mega, 256, 0);
    if (per_cu < 1) per_cu = 1;
    if (per_cu > 2) per_cu = 2;
    grid_blocks = cus * per_cu;
  }
  Params p{};
  const float** f = (const float**)&p;
  for (int i = 0; i < 29; i++) f[i] = (const float*)d_in[i];
  p.out = (float*)d_out;
  p.ws = (char*)d_ws;
  hipMemsetAsync((char*)d_ws + OFF_BAR, 0, XCD_BAR_WORDS * 4, stream);
  void* args[] = {&p};
  hipError_t e = hipLaunchCooperativeKernel((void*)mega, dim3(grid_blocks), dim3(256), args, 0, stream);
  if (e != hipSuccess) fprintf(stderr, "cooperative launch failed: %s (grid %d)\n", hipGetErrorString(e), grid_blocks);
}
```
